# Optimizing an MI355X kernel written in HIP

```python
import math
import jax, jax.numpy as jnp
from jax import lax
import numpy as np

D_MODEL = 1024
BATCH = 32
SEQ = 2048
DEPTH = 4

CTX_LEN = 256
GRID_W = 64
CHUNK = 128

ML_HEADS = 4
ML_DH = 64
ML_W = ML_HEADS * ML_DH
ML_CONV = 3

DA_HEADS = 4
DA_DQK = 64
DA_DV = 2 * DA_DQK
DA_W = DA_HEADS * DA_DV

SG_GROUPS = 4
SG_W = 256
SG_DG = SG_W // SG_GROUPS

D_MIX = ML_W + DA_W + SG_W
ROPE_BASE = 10000.0
LN_EPS = 1e-5
DEEPNORM_ALPHA = (2 * DEPTH) ** 0.25
DEEPNORM_BETA = (8 * DEPTH) ** -0.25

COL_SPLIT = (('ml_qk', 2 * ML_W), ('ml_v', ML_W), ('ml_o', ML_W), ('ml_z', ML_W),
             ('ml_gates', 4 * ML_HEADS), ('da_q', DA_W), ('da_k', DA_W), ('da_v', DA_W),
             ('da_z', DA_W), ('sg_u', SG_W), ('sg_v', SG_W), ('sg_z', SG_W))
D_IN = sum(w for _, w in COL_SPLIT)

kernel_name = 'hybrid_mlstm_diffattn_sgu_prefix_block'

F32 = jnp.float32


def layer_norm(x):
    xf = x.astype(F32)
    xc = xf - jnp.mean(xf, -1, keepdims=True)
    return xc * lax.rsqrt(jnp.mean(xc * xc, -1, keepdims=True) + LN_EPS)


def split_cols(p):
    out, off = {}, 0
    for name, w in COL_SPLIT:
        out[name] = p[..., off:off + w]
        off += w
    return out


def dwconv_centred(x, w, b):
    y = lax.conv_general_dilated(x, w[:, None, :].astype(x.dtype), window_strides=(1,),
                                 padding=[(ML_CONV // 2, ML_CONV // 2)],
                                 dimension_numbers=('NWC', 'WIO', 'NWC'),
                                 feature_group_count=x.shape[-1])
    return y + b


def mlstm_zero_state(batch):
    return (jnp.zeros((batch, ML_HEADS, ML_DH, ML_DH), F32),
            jnp.zeros((batch, ML_HEADS, ML_DH), F32),
            jnp.zeros((batch, ML_HEADS), F32))


def mlstm_chunkwise(q, k, v, log_i, log_f, state0, want_h):
    bsz, nh, length, dh = q.shape
    nc = length // CHUNK
    to_chunks = lambda t: t.astype(F32).reshape(bsz, nh, nc, CHUNK, *t.shape[3:])
    qc, kc, vc = to_chunks(q), to_chunks(k), to_chunks(v)
    ic, fc = to_chunks(log_i), to_chunks(log_f)
    b = jnp.cumsum(fc, axis=-1)
    b_end = b[..., -1]
    g = b_end[..., None] - b + ic
    m_loc = jnp.max(g, -1)
    w = jnp.exp(g - m_loc[..., None])
    c_loc = jnp.einsum('bhcs,bhcsv,bhcsk->bhcvk', w, vc, kc)
    n_loc = jnp.einsum('bhcs,bhcsk->bhck', w, kc)

    def step(carry, xs):
        c_st, n_st, m_st = carry
        cl, nl, ml, be = xs
        m_new = jnp.maximum(be + m_st, ml)
        a = jnp.exp(be + m_st - m_new)
        s = jnp.exp(ml - m_new)
        c_new = a[..., None, None] * c_st + s[..., None, None] * cl
        n_new = a[..., None] * n_st + s[..., None] * nl
        return (c_new, n_new, m_new), carry

    lead = lambda t: jnp.moveaxis(t, 2, 0)
    final, starts = lax.scan(step, state0, (lead(c_loc), lead(n_loc), lead(m_loc), lead(b_end)))
    if not want_h:
        return None, final
    c_prev, n_prev, m_prev = (jnp.moveaxis(t, 0, 2) for t in starts)
    a_log = b + m_prev[..., None]
    d_log = b[..., :, None] - b[..., None, :] + ic[..., None, :]
    mask = jnp.tril(jnp.ones((CHUNK, CHUNK), bool))
    d_log = jnp.where(mask, d_log, -jnp.inf)
    m_j = jnp.maximum(a_log, jnp.max(d_log, -1))
    w_inter = jnp.exp(a_log - m_j)
    s = jnp.einsum('bhcjd,bhcsd->bhcjs', qc, kc) * jnp.exp(d_log - m_j[..., None])
    num = (w_inter[..., None] * jnp.einsum('bhcvk,bhcjk->bhcjv', c_prev, qc)
           + jnp.einsum('bhcjs,bhcsv->bhcjv', s, vc))
    den = w_inter * jnp.einsum('bhck,bhcjk->bhcj', n_prev, qc) + jnp.sum(s, -1)
    h = num / jnp.maximum(jnp.abs(den), jnp.exp(-m_j))[..., None]
    return h.reshape(bsz, nh, length, dh), final


def mlstm_inputs(sp, conv_w, conv_b):
    bsz, length, _ = sp['ml_v'].shape
    qk = jax.nn.silu(dwconv_centred(sp['ml_qk'], conv_w, conv_b))
    heads = lambda t: t.reshape(bsz, length, ML_HEADS, ML_DH).transpose(0, 2, 1, 3)
    q = heads(qk[..., :ML_W])
    k = heads(qk[..., ML_W:]) * (ML_DH ** -0.5)
    v = heads(sp['ml_v'])
    gates = sp['ml_gates'].astype(F32).reshape(bsz, length, 4, ML_HEADS).transpose(2, 0, 3, 1)
    fwd = (gates[0], jax.nn.log_sigmoid(gates[1]))
    bwd = (gates[2], jax.nn.log_sigmoid(gates[3]))
    return q, k, v, fwd, bwd


def mlstm_bidir(q, k, v, fwd, bwd, state_f, state_b, want_h):
    flip = lambda t: jnp.flip(t, axis=2)
    h_f, fin_f = mlstm_chunkwise(q, k, v, fwd[0], fwd[1], state_f, want_h)
    h_b, fin_b = mlstm_chunkwise(flip(q), flip(k), flip(v), flip(bwd[0]), flip(bwd[1]), state_b, want_h)
    h = h_f + flip(h_b) if want_h else None
    return h, fin_f, fin_b


def mlstm_output(h, sp, norm_g):
    bsz, length, _ = sp['ml_o'].shape
    h = h.transpose(0, 2, 1, 3)
    o = jax.nn.sigmoid(sp['ml_o'].astype(F32)).reshape(bsz, length, ML_HEADS, ML_DH)
    y = layer_norm(o * h).reshape(bsz, length, ML_W) * norm_g
    return (y * jax.nn.silu(sp['ml_z'].astype(F32))).astype(sp['ml_z'].dtype)


def axial_rope_tables(n_tokens):
    n_rows = n_tokens // GRID_W
    row = jnp.repeat(jnp.arange(n_rows, dtype=F32), GRID_W)
    col = jnp.tile(jnp.arange(GRID_W, dtype=F32), n_rows)
    half = DA_DQK // 2
    inv = ROPE_BASE ** (-jnp.arange(0, half, 2, dtype=F32) / half)
    ang_r, ang_c = row[:, None] * inv, col[:, None] * inv
    ang = jnp.concatenate([ang_r, ang_r, ang_c, ang_c], -1)
    return jnp.cos(ang), jnp.sin(ang)


def rotate_half(t):
    t1, t2 = jnp.split(t, 2, -1)
    return jnp.concatenate([-t2, t1], -1)


def apply_axial_rope(t, cos, sin):
    tf = t.astype(F32)
    tr, tc = jnp.split(tf, 2, -1)
    rot = jnp.concatenate([rotate_half(tr), rotate_half(tc)], -1)
    return (tf * cos[None, :, None, None, :] + rot * sin[None, :, None, None, :]).astype(t.dtype)


def diff_attn_heads(sp):
    bsz, length, _ = sp['da_q'].shape
    q = sp['da_q'].reshape(bsz, length, DA_HEADS, 2, DA_DQK)
    k = sp['da_k'].reshape(bsz, length, DA_HEADS, 2, DA_DQK)
    v = sp['da_v'].reshape(bsz, length, DA_HEADS, DA_DV)
    return q, k, v


def diff_attn_core(q, k, v, lam):
    s = jnp.einsum('bqhcd,bkhcd->bhcqk', q, k, preferred_element_type=F32) * (DA_DQK ** -0.5)
    p = jax.nn.softmax(s, axis=-1)
    a = p[:, :, 0] - lam * p[:, :, 1]
    return jnp.einsum('bhqk,bkhv->bqhv', a.astype(v.dtype), v)


def diff_attn_blocked(q, k, v, lam):
    bsz, length = q.shape[:2]
    nb = length // CHUNK
    qb = jnp.moveaxis(q.reshape(bsz, nb, CHUNK, *q.shape[2:]), 1, 0)
    ob = lax.map(lambda qq: diff_attn_core(qq, k, v, lam), qb)
    return jnp.moveaxis(ob, 0, 1).reshape(bsz, length, DA_HEADS, DA_DV)


def diff_attn_output(o, sp, norm_g, lam_init):
    bsz, length = o.shape[:2]
    of = o.astype(F32)
    y = of * lax.rsqrt(jnp.mean(of * of, -1, keepdims=True) + LN_EPS) * norm_g * (1.0 - lam_init)
    return (y.reshape(bsz, length, DA_W) * jax.nn.silu(sp['da_z'].astype(F32))).astype(sp['da_z'].dtype)


def spatial_gating(sp, norm_g, norm_b, w_s, b_s):
    bsz, length, _ = sp['sg_u'].shape
    nc = length // CHUNK
    u = jax.nn.gelu(sp['sg_u'].astype(F32), approximate=False)
    v = layer_norm(jax.nn.gelu(sp['sg_v'].astype(F32), approximate=False)) * norm_g + norm_b
    vg = v.reshape(bsz, nc, CHUNK, SG_GROUPS, SG_DG)
    vs = jnp.einsum('gpq,bcqgd->bcpgd', w_s.astype(F32), vg) + b_s.T[:, :, None]
    y = u * vs.reshape(bsz, length, SG_W)
    return (y * jax.nn.silu(sp['sg_z'].astype(F32))).astype(sp['sg_z'].dtype)


def hybrid_layer(xl, xc, c, c_ctx, w_mod, b_mod, w_in, b_in, conv_w, conv_b, ml_g,
                 lq1, lk1, lq2, lk2, da_g, sg_g, sg_b, w_s, b_s, w_out, ln_g, ln_b,
                 lam_init, cos, sin, need_ctx_out):
    dt = xl.dtype
    shift, scale, gate = jnp.split(jax.nn.silu(c) @ w_mod + b_mod, 3, -1)
    shift_c, scale_c, gate_c = jnp.split(jax.nn.silu(c_ctx) @ w_mod + b_mod, 3, -1)
    hl = (layer_norm(xl) * (1.0 + scale[:, None]) + shift[:, None]).astype(dt)
    hc = (layer_norm(xc) * (1.0 + scale_c) + shift_c).astype(xc.dtype)
    pl = split_cols(hl @ w_in + b_in)
    pc = split_cols(hc @ w_in + b_in)

    q_l, k_l, v_l, fwd_l, bwd_l = mlstm_inputs(pl, conv_w, conv_b)
    q_c, k_c, v_c, fwd_c, bwd_c = mlstm_inputs(pc, conv_w, conv_b)
    zero = mlstm_zero_state(xc.shape[0])
    h_c, st_f, st_b = mlstm_bidir(q_c, k_c, v_c, fwd_c, bwd_c, zero, zero, need_ctx_out)
    h_l, _, _ = mlstm_bidir(q_l, k_l, v_l, fwd_l, bwd_l, st_f, st_b, True)
    ml_l = mlstm_output(h_l, pl, ml_g)

    lam = (jnp.exp(jnp.sum(lq1.astype(F32) * lk1.astype(F32)))
           - jnp.exp(jnp.sum(lq2.astype(F32) * lk2.astype(F32))) + lam_init)
    dq_l, dk_l, dv_l = diff_attn_heads(pl)
    dq_c, dk_c, dv_c = diff_attn_heads(pc)
    dq_l = apply_axial_rope(dq_l, cos, sin)
    dk_l = apply_axial_rope(dk_l, cos, sin)
    k_all = jnp.concatenate([dk_l, dk_c], axis=1)
    v_all = jnp.concatenate([dv_l, dv_c], axis=1)
    da_l = diff_attn_output(diff_attn_blocked(dq_l, k_all, v_all, lam), pl, da_g, lam_init)

    sg_l = spatial_gating(pl, sg_g, sg_b, w_s, b_s)

    y_l = jnp.concatenate([ml_l, da_l, sg_l], -1) @ w_out
    xl_new = (layer_norm(DEEPNORM_ALPHA * xl + gate[:, None] * y_l) * ln_g + ln_b).astype(dt)
    if not need_ctx_out:
        return xl_new, None
    ml_c = mlstm_output(h_c, pc, ml_g)
    da_c = diff_attn_output(diff_attn_core(dq_c, dk_c, dv_c, lam), pc, da_g, lam_init)
    sg_c = spatial_gating(pc, sg_g, sg_b, w_s, b_s)
    y_c = jnp.concatenate([ml_c, da_c, sg_c], -1) @ w_out
    xc_new = (layer_norm(DEEPNORM_ALPHA * xc + gate_c * y_c) * ln_g + ln_b).astype(xc.dtype)
    return xl_new, xc_new


def setup_inputs(seed: int = 0) -> dict:
    key = jax.random.key(seed)
    ks = jax.random.split(key, 24)
    nrm = lambda k, shape, s: s * jax.random.normal(k, shape, F32)
    off = 0
    for name, w in COL_SPLIT:
        if name == 'ml_gates':
            break
        off += w
    bias_off = np.zeros((D_IN,), np.float32)
    f_init = np.linspace(3.0, 6.0, ML_HEADS).astype(np.float32)
    bias_off[off + ML_HEADS:off + 2 * ML_HEADS] = f_init
    bias_off[off + 3 * ML_HEADS:off + 4 * ML_HEADS] = f_init
    return {
        'x': nrm(ks[0], (BATCH, SEQ, D_MODEL), 1.0),
        'c': nrm(ks[1], (BATCH, D_MODEL), 1.0),
        'ctx': nrm(ks[2], (BATCH, CTX_LEN, D_MODEL), 1.0),
        'c_ctx': nrm(ks[3], (D_MODEL,), 1.0),
        'w_mod': nrm(ks[4], (DEPTH, D_MODEL, 3 * D_MODEL), D_MODEL ** -0.5),
        'b_mod': nrm(ks[5], (DEPTH, 3 * D_MODEL), 0.02),
        'w_in': nrm(ks[6], (DEPTH, D_MODEL, D_IN), D_MODEL ** -0.5),
        'b_in': nrm(ks[7], (DEPTH, D_IN), 0.02) + jnp.asarray(bias_off),
        'ml_conv_w': nrm(ks[8], (DEPTH, ML_CONV, 2 * ML_W), ML_CONV ** -0.5),
        'ml_conv_b': nrm(ks[9], (DEPTH, 2 * ML_W), 0.02),
        'ml_norm_g': 1.0 + nrm(ks[10], (DEPTH, ML_W), 0.02),
        'da_lam_q1': nrm(ks[11], (DEPTH, DA_DQK), 0.1),
        'da_lam_k1': nrm(ks[12], (DEPTH, DA_DQK), 0.1),
        'da_lam_q2': nrm(ks[13], (DEPTH, DA_DQK), 0.1),
        'da_lam_k2': nrm(ks[14], (DEPTH, DA_DQK), 0.1),
        'da_norm_g': 1.0 + nrm(ks[15], (DEPTH, DA_DV), 0.02),
        'sg_norm_g': 1.0 + nrm(ks[16], (DEPTH, SG_W), 0.02),
        'sg_norm_b': nrm(ks[17], (DEPTH, SG_W), 0.02),
        'sg_w_s': nrm(ks[18], (DEPTH, SG_GROUPS, CHUNK, CHUNK), CHUNK ** -0.5),
        'sg_b_s': 1.0 + nrm(ks[19], (DEPTH, SG_GROUPS, CHUNK), 0.02),
        'w_out': nrm(ks[20], (DEPTH, D_MIX, D_MODEL), DEEPNORM_BETA * D_MIX ** -0.5),
        'ln_g': 1.0 + nrm(ks[21], (DEPTH, D_MODEL), 0.02),
        'ln_b': nrm(ks[22], (DEPTH, D_MODEL), 0.02),
    }


def reference(x, c, ctx, c_ctx, w_mod, b_mod, w_in, b_in, ml_conv_w, ml_conv_b, ml_norm_g,
              da_lam_q1, da_lam_k1, da_lam_q2, da_lam_k2, da_norm_g, sg_norm_g, sg_norm_b,
              sg_w_s, sg_b_s, w_out, ln_g, ln_b):
    cos, sin = axial_rope_tables(x.shape[1])
    xl, xc = x, ctx
    for l in range(DEPTH):
        lam_init = 0.8 - 0.6 * math.exp(-0.3 * l)
        xl, xc = hybrid_layer(xl, xc, c, c_ctx, w_mod[l], b_mod[l], w_in[l], b_in[l],
                              ml_conv_w[l], ml_conv_b[l], ml_norm_g[l],
                              da_lam_q1[l], da_lam_k1[l], da_lam_q2[l], da_lam_k2[l], da_norm_g[l],
                              sg_norm_g[l], sg_norm_b[l], sg_w_s[l], sg_b_s[l], w_out[l],
                              ln_g[l], ln_b[l], lam_init, cos, sin, l < DEPTH - 1)
    return xl
```

```cpp
#include <hip/hip_runtime.h>
#include <hip/hip_cooperative_groups.h>
#include <cstdio>
#include <cstdint>
namespace cg = cooperative_groups;

constexpr int DM = 1024, NBATCH = 32, SEQ = 2048, CTXL = 256, DEPTH = 4;
constexpr int ML = NBATCH * SEQ, MCX = NBATCH * CTXL, MTOT = ML + MCX;
constexpr int NIN = 4352, NINR = 4112;
constexpr int C_MLQ = 0, C_MLK = 256, C_MLV = 512, C_MLO = 768, C_MLZ = 1024, C_DAQ = 1280, C_DAK = 1792, C_DAV = 2304, C_DAZ = 2816,
              C_SGU = 3328, C_SGV = 3584, C_SGZ = 3840, C_GATE = 4096;
constexpr float LN_EPS = 1e-5f;
constexpr float DN_ALPHA = 1.681792830507429f;
constexpr float QSCALE = 0.125f * 1.4426950408889634f;

template <int O> __device__ __forceinline__ float xshf(float v) {
    if constexpr (O < 32) { return __int_as_float(__builtin_amdgcn_ds_swizzle(__float_as_int(v), (O << 10) | 0x1f)); }
    else { const auto r = __builtin_amdgcn_permlane32_swap(__float_as_uint(v), __float_as_uint(v), false, false);
           return __uint_as_float((threadIdx.x & 32) ? r[0] : r[1]); }
}
__device__ __forceinline__ float lshf(float v, int src_lane) { return __int_as_float(__builtin_amdgcn_ds_bpermute(src_lane << 2, __float_as_int(v))); }
namespace pg8 {
#define PG8_LAS __attribute__((address_space(3)))
typedef unsigned short bf16_t;
typedef short bf16x8 __attribute__((ext_vector_type(8)));
typedef float f32x4 __attribute__((ext_vector_type(4)));
typedef unsigned u32x4 __attribute__((ext_vector_type(4)));
constexpr int BM = 256, BK = 64, HALF = 128, HTB = HALF * BK * 2  , STAGE_BYTES = 8 * HTB, NXCD = 8, WGM = 8;

__host__ __device__ __forceinline__ int lds_byte(int r, int c) { const int st = (r >> 4) * 2 + (c >> 5), rr = r & 15, cc = c & 31, ob = rr * 64 + cc * 2; return st * 1024 + (ob ^ (((ob >> 9) & 1) << 5)); }
__host__ __device__ __forceinline__ void stage_rc(int b, int& R, int& C) { const int st = b / 1024, sb = b % 1024, swz = sb ^ (((sb >> 9) & 1) << 5); R = (st >> 1) * 16 + swz / 64; C = (st & 1) * 32 + (swz % 64) / 2; }
__host__ __device__ __forceinline__ int perm32(int rho) { const int n = rho >> 4, i = rho & 15; return 8 * (i >> 2) + 4 * n + (i & 3); }

struct Unit { int pm, pn; };
struct Gemm { const bf16_t* A; const bf16_t* Bt; int M, N, K; };

struct StaticOrder {
    int nM, nN, nwg, G, c;
    __host__ __device__ void init(int M, int N, int G_, int c_) { nM = M / BM; nN = N / BM; nwg = nM * nN; G = G_; c = c_; }
    __host__ __device__ bool next(int i, Unit& u) const {
        const long L = (long)i * G + c; if (L >= nwg) return false;
        int wgid = (int)L; { const int q = nwg / NXCD, r = nwg % NXCD, xcd = wgid % NXCD, off = wgid / NXCD; wgid = (xcd < r ? xcd * (q + 1) : r * (q + 1) + (xcd - r) * q) + off; }
        const int nig = WGM * nN, gid = wgid / nig, fm = gid * WGM, gsz = (nM - fm) < WGM ? (nM - fm) : WGM;
        u.pm = fm + ((wgid % nig) % gsz); u.pn = (wgid % nig) / gsz; return true;
    }
    __device__ __forceinline__ void a_ready(const Unit&) const {}
    __device__ __forceinline__ void done(const Unit&) const {}
};
__device__ __forceinline__ unsigned cvt_pk_bf16(float lo, float hi) { unsigned r; asm volatile("v_cvt_pk_bf16_f32 %0, %1, %2" : "=v"(r) : "v"(lo), "v"(hi)); return r; }
typedef float f32x2 __attribute__((ext_vector_type(2)));
typedef float f32x2 __attribute__((ext_vector_type(2)));
struct EpiIn {
    static constexpr bool PERM = true, AFTER_DRAIN = false;
    bf16_t* P; float* GATES; const float* bias; const float* rope;
    __device__ __forceinline__ void operator()(const f32x4 (&acc)[2][2][4][2], const Unit& u, int wr, int wc, int fr, int fq) const {
        const int row0 = u.pm * BM + wr * 64 + fr, colt = u.pn * BM, col0 = colt + wc * 32 + 8 * fq;
        const bool is_lat = u.pm < (ML / BM);
        const int mode = (u.pn == 5 || u.pn == 6) ? 1 : ((u.pn == 7 || u.pn == 8) ? 2 : (u.pn == 16 ? 3 : 0));
        const bool do_rope = (mode == 1 || mode == 2) && is_lat;
        const float sgn = (fq < 2) ? -1.f : 1.f;
        f32x4 bv[2][2];
#pragma unroll
        for (int bj = 0; bj < 2; ++bj)
#pragma unroll
            for (int n = 0; n < 2; ++n) bv[bj][n] = *(const f32x4*)(bias + col0 + bj * HALF + 4 * n);
#pragma unroll
        for (int ai = 0; ai < 2; ++ai)
#pragma unroll
            for (int m = 0; m < 4; ++m) {
                const int row = row0 + ai * HALF + m * 16;
                const int t = row & (SEQ - 1);
                const int pidx = (wc & 1) ? 32 + (t & 63) : (t >> 6);
                const float* tab = rope + (pidx * 16 + 8 * (fq & 1)) * 2;
#pragma unroll
                for (int bj = 0; bj < 2; ++bj) {
                    f32x4 v0 = acc[ai][bj][m][0] + bv[bj][0], v1 = acc[ai][bj][m][1] + bv[bj][1];
                    if (mode == 1 || mode == 2) {
                        f32x4 p0, p1;
#pragma unroll
                        for (int e = 0; e < 4; ++e) { p0[e] = xshf<32>(v0[e]); p1[e] = xshf<32>(v1[e]); }
                        if (do_rope) {
                            const f32x4 t0 = *(const f32x4*)(tab), t1 = *(const f32x4*)(tab + 4), t2 = *(const f32x4*)(tab + 8), t3 = *(const f32x4*)(tab + 12);
                            v0[0] = v0[0] * t0[0] + sgn * p0[0] * t0[1]; v0[1] = v0[1] * t0[2] + sgn * p0[1] * t0[3];
                            v0[2] = v0[2] * t1[0] + sgn * p0[2] * t1[1]; v0[3] = v0[3] * t1[2] + sgn * p0[3] * t1[3];
                            v1[0] = v1[0] * t2[0] + sgn * p1[0] * t2[1]; v1[1] = v1[1] * t2[2] + sgn * p1[1] * t2[3];
                            v1[2] = v1[2] * t3[0] + sgn * p1[2] * t3[1]; v1[3] = v1[3] * t3[2] + sgn * p1[3] * t3[3];
                        }
                        if (mode == 1) { v0 = v0 * QSCALE; v1 = v1 * QSCALE; }
                    }
                    if (mode == 3) {
                        if (wc == 0 && bj == 0 && fq < 2) { float* gp = GATES + (size_t)row * 16 + 8 * fq; *(f32x4*)gp = v0; *(f32x4*)(gp + 4) = v1; }
                    } else {
                        u32x4 w; w.x = cvt_pk_bf16(v0[0], v0[1]); w.y = cvt_pk_bf16(v0[2], v0[3]); w.z = cvt_pk_bf16(v1[0], v1[1]); w.w = cvt_pk_bf16(v1[2], v1[3]);
                        __builtin_nontemporal_store(w, (u32x4*)(P + (size_t)row * NIN + col0 + bj * HALF));
                    }
                }
            }
    }
};
struct EpiOut {
    static constexpr bool PERM = false, AFTER_DRAIN = false;
    const float* src_lat; const float* src_ctx; float* dst_lat; float* dst_ctx; const float* gate;
    const float* stats; const float* lng; const float* lnb; int use_ln;
    __device__ __forceinline__ void operator()(const f32x4 (&acc)[2][2][4][2], const Unit& u, int wr, int wc, int fr, int fq) const {
        const int rowt = u.pm * BM; const bool is_lat = u.pm < (ML / BM);
        const int bidx = is_lat ? (rowt >> 11) : 32;
        const float* src = is_lat ? src_lat + (size_t)rowt * DM : src_ctx + (size_t)(rowt - ML) * DM;
        float* dst = is_lat ? dst_lat + (size_t)rowt * DM : dst_ctx + (size_t)(rowt - ML) * DM;
        const int col0 = u.pn * BM + wc * 32 + 4 * fq;
        const float* g = gate + (size_t)bidx * 3072;
        f32x4 gv[2][2], lg[2][2], lb[2][2];
#pragma unroll
        for (int bj = 0; bj < 2; ++bj)
#pragma unroll
            for (int n = 0; n < 2; ++n) { gv[bj][n] = *(const f32x4*)(g + col0 + bj * HALF + n * 16);
                if (use_ln) { lg[bj][n] = *(const f32x4*)(lng + col0 + bj * HALF + n * 16); lb[bj][n] = *(const f32x4*)(lnb + col0 + bj * HALF + n * 16); }
                else { lg[bj][n] = (f32x4){1.f, 1.f, 1.f, 1.f}; lb[bj][n] = (f32x4){0.f, 0.f, 0.f, 0.f}; } }
#pragma unroll
        for (int ai = 0; ai < 2; ++ai)
#pragma unroll
            for (int m = 0; m < 4; ++m) {
                const int r = ai * HALF + wr * 64 + m * 16 + fr;
                const size_t off = (size_t)r * DM + col0;
                float mean = 0.f, rstd = 1.f;
                if (use_ln) { const f32x2 st = *(const f32x2*)(stats + (size_t)(rowt + r) * 2); mean = st.x; rstd = st.y; }
#pragma unroll
                for (int bj = 0; bj < 2; ++bj)
#pragma unroll
                    for (int n = 0; n < 2; ++n) {
                        const f32x4 rv = __builtin_nontemporal_load((const f32x4*)(src + off + bj * HALF + n * 16));
                        const f32x4 xv = (rv - mean) * rstd * lg[bj][n] + lb[bj][n];
                        __builtin_nontemporal_store(xv * DN_ALPHA + gv[bj][n] * acc[ai][bj][m][n], (f32x4*)(dst + off + bj * HALF + n * 16));
                    }
            }
    }
};
template <class Epi, class Sched, bool ALIGN_EPI = false, bool SP2 = false>
__device__ __forceinline__ void gemm_phase(PG8_LAS unsigned char* lds, const Gemm g, const Sched& S, const Epi& E) {
    int tid_l = threadIdx.x; asm volatile("" : "+v"(tid_l));
    const int tid = tid_l, wid = __builtin_amdgcn_readfirstlane(tid >> 6), lane = tid & 63, wr = wid >> 2, wc = wid & 3, fr = lane & 15, fq = lane >> 4;
    const int K = g.K, nt = K / BK;
    unsigned voffA[2], voffB[2];
#pragma unroll
    for (int i = 0; i < 2; ++i) { int R, C; stage_rc(tid * 16 + i * 8192, R, C); const int Rb = Epi::PERM ? ((R & ~31) + perm32(R & 31)) : R;
        voffA[i] = (unsigned)(R * K + C) * 2u; voffB[i] = (unsigned)(Rb * K + C) * 2u; }
    const size_t kstep = (size_t)(BK * 2);
    const size_t hstep = (size_t)HALF * K * 2;
    const size_t tstep = 2 * hstep;
    const unsigned ldsw = (unsigned)wid * 1024u;
    const int aoff = lds_byte(wr * 64 + fr, fq * 8), boff = lds_byte(wc * 32 + fr, fq * 8);
#define PG8_SA(b, h) (((b) * 2 + (h)) * HTB)
#define PG8_SB(b, h) ((4 + (b) * 2 + (h)) * HTB)
#define PG8_STAGE(bufoff, gbase, voff) do { _Pragma("unroll") for (int _i = 0; _i < 2; ++_i) \
        __builtin_amdgcn_global_load_lds((const unsigned*)((const char*)(gbase) + (voff)[_i]), (PG8_LAS unsigned*)(lds + (bufoff) + ldsw + _i * 8192), 16, 0, 0); } while (0)
#define PG8_LDA(dst, b, h) do { _Pragma("unroll") for (int m = 0; m < 4; ++m) _Pragma("unroll") for (int k = 0; k < 2; ++k) dst[m][k] = *(const PG8_LAS bf16x8*)(lds + PG8_SA(b, h) + aoff + m * 2048 + k * 1024); } while (0)
#define PG8_LDB(dst, b, h) do { _Pragma("unroll") for (int n = 0; n < 2; ++n) _Pragma("unroll") for (int k = 0; k < 2; ++k) dst[n][k] = *(const PG8_LAS bf16x8*)(lds + PG8_SB(b, h) + boff + n * 2048 + k * 1024); } while (0)
#define PG8_MMA(ai, bj, At, Bt) do { __builtin_amdgcn_s_setprio(1); _Pragma("unroll") for (int m = 0; m < 4; ++m) _Pragma("unroll") for (int n = 0; n < 2; ++n) _Pragma("unroll") for (int k = 0; k < 2; ++k) \
        acc[ai][bj][m][n] = __builtin_amdgcn_mfma_f32_16x16x32_bf16(Bt[n][k], At[m][k], acc[ai][bj][m][n], 0, 0, 0); __builtin_amdgcn_s_setprio(0); } while (0)
#define PG8_WAIT_V(n) asm volatile("s_waitcnt vmcnt(" #n ")" ::: "memory")
#define PG8_WAIT_L(n) asm volatile("s_waitcnt lgkmcnt(" #n ")" ::: "memory")
#define PG8_BAR __builtin_amdgcn_s_barrier()
#define PG8_SCHED __builtin_amdgcn_sched_barrier(0)
    Unit cur, nxt; int ui = 0;
    if (!S.next(0, cur)) return;
    f32x4 acc[2][2][4][2];
#pragma unroll
    for (int a = 0; a < 2; ++a)
#pragma unroll
        for (int b = 0; b < 2; ++b)
#pragma unroll
            for (int m = 0; m < 4; ++m)
#pragma unroll
                for (int n = 0; n < 2; ++n) acc[a][b][m][n] = (f32x4){0.f, 0.f, 0.f, 0.f};
    bf16x8 At[4][2], B0[2][2], B1[2][2];
    const char* cA = (const char*)g.A + (size_t)cur.pm * tstep; const char* cB = (const char*)g.Bt + (size_t)cur.pn * tstep;
    S.a_ready(cur);
    if constexpr (SP2) {
        PG8_STAGE(PG8_SB(0, 0), cB, voffB); PG8_STAGE(PG8_SB(0, 1), cB + hstep, voffB); PG8_STAGE(PG8_SA(0, 0), cA, voffA); PG8_STAGE(PG8_SA(0, 1), cA + hstep, voffA);
        if (wr == 1) PG8_BAR;
        PG8_WAIT_V(2); PG8_BAR;
        PG8_STAGE(PG8_SB(1, 0), cB + kstep, voffB); PG8_STAGE(PG8_SA(1, 0), cA + kstep, voffA); PG8_STAGE(PG8_SB(1, 1), cB + hstep + kstep, voffB);
        PG8_WAIT_V(6); PG8_BAR;
    } else {
        PG8_STAGE(PG8_SB(0, 0), cB, voffB); PG8_STAGE(PG8_SA(0, 0), cA, voffA); PG8_STAGE(PG8_SB(0, 1), cB + hstep, voffB); PG8_STAGE(PG8_SA(0, 1), cA + hstep, voffA);
        if (wr == 1) PG8_BAR;
        PG8_WAIT_V(4); PG8_BAR;
        PG8_STAGE(PG8_SB(1, 0), cB + kstep, voffB); PG8_STAGE(PG8_SA(1, 0), cA + kstep, voffA); PG8_STAGE(PG8_SB(1, 1), cB + hstep + kstep, voffB);
        PG8_WAIT_V(6); PG8_BAR;
    }
    for (;;) {
        const bool has_next = S.next(ui + 1, nxt);
        const char* nA = has_next ? (const char*)g.A + (size_t)nxt.pm * tstep : cA; const char* nB = has_next ? (const char*)g.Bt + (size_t)nxt.pn * tstep : cB;
        for (int t = 0; t < nt; t += 2) {
            const bool last = (t == nt - 2);
            const char* a1 = cA + (size_t)(t + 1) * kstep;
            const char* a2 = last ? nA : cA + (size_t)(t + 2) * kstep; const char* b2 = last ? nB : cB + (size_t)(t + 2) * kstep;
            const char* a3 = a2 + kstep; const char* b3 = b2 + kstep;
            if (last && has_next) S.a_ready(nxt);
            if constexpr (SP2) {
            PG8_LDB(B0, 0, 0); PG8_LDB(B1, 0, 1); PG8_SCHED; PG8_LDA(At, 0, 0); PG8_STAGE(PG8_SA(1, 1), a1 + hstep, voffA);
            PG8_WAIT_V(8); PG8_WAIT_L(0); PG8_BAR; PG8_MMA(0, 0, At, B0); PG8_MMA(0, 1, At, B1); PG8_BAR; PG8_SCHED;
            PG8_LDA(At, 0, 1); PG8_STAGE(PG8_SB(0, 0), b2, voffB); PG8_STAGE(PG8_SB(0, 1), b2 + hstep, voffB); PG8_STAGE(PG8_SA(0, 0), a2, voffA);
            PG8_WAIT_V(8); PG8_WAIT_L(0); PG8_BAR; PG8_MMA(1, 0, At, B0); PG8_MMA(1, 1, At, B1); PG8_BAR; PG8_SCHED;
            PG8_LDB(B0, 1, 0); PG8_LDB(B1, 1, 1); PG8_SCHED; PG8_LDA(At, 1, 0); PG8_STAGE(PG8_SA(0, 1), a2 + hstep, voffA);
            PG8_WAIT_V(8); PG8_WAIT_L(0); PG8_BAR; PG8_MMA(0, 0, At, B0); PG8_MMA(0, 1, At, B1); PG8_BAR; PG8_SCHED;
            PG8_LDA(At, 1, 1); PG8_STAGE(PG8_SB(1, 0), b3, voffB); PG8_STAGE(PG8_SB(1, 1), b3 + hstep, voffB); PG8_STAGE(PG8_SA(1, 0), a3, voffA);
            PG8_WAIT_V(8); PG8_WAIT_L(0); PG8_BAR; PG8_MMA(1, 0, At, B0); PG8_MMA(1, 1, At, B1); PG8_BAR; PG8_SCHED;
            } else {
            PG8_LDB(B0, 0, 0); PG8_SCHED; PG8_LDA(At, 0, 0); PG8_STAGE(PG8_SA(1, 1), a1 + hstep, voffA);
            PG8_WAIT_L(8); PG8_BAR; PG8_WAIT_L(0); PG8_MMA(0, 0, At, B0); PG8_BAR; PG8_SCHED;
            PG8_LDB(B1, 0, 1); PG8_STAGE(PG8_SB(0, 0), b2, voffB);
            PG8_BAR; PG8_WAIT_L(0); PG8_MMA(0, 1, At, B1); PG8_BAR;
            PG8_LDA(At, 0, 1); PG8_STAGE(PG8_SA(0, 0), a2, voffA);
            PG8_BAR; PG8_WAIT_L(0); PG8_MMA(1, 0, At, B0); PG8_BAR; PG8_SCHED;
            PG8_STAGE(PG8_SB(0, 1), b2 + hstep, voffB);
            PG8_WAIT_V(6); PG8_BAR; PG8_MMA(1, 1, At, B1); PG8_BAR;
            PG8_LDB(B0, 1, 0); PG8_SCHED; PG8_LDA(At, 1, 0); PG8_STAGE(PG8_SA(0, 1), a2 + hstep, voffA);
            PG8_WAIT_L(8); PG8_BAR; PG8_WAIT_L(0); PG8_MMA(0, 0, At, B0); PG8_BAR; PG8_SCHED;
            PG8_LDB(B1, 1, 1); PG8_STAGE(PG8_SB(1, 0), b3, voffB);
            PG8_BAR; PG8_WAIT_L(0); PG8_MMA(0, 1, At, B1); PG8_BAR;
            PG8_LDA(At, 1, 1); PG8_STAGE(PG8_SA(1, 0), a3, voffA);
            PG8_BAR; PG8_WAIT_L(0); PG8_MMA(1, 0, At, B0); PG8_BAR; PG8_SCHED;
            PG8_STAGE(PG8_SB(1, 1), b3 + hstep, voffB);
            PG8_WAIT_V(6); PG8_BAR; PG8_MMA(1, 1, At, B1); PG8_BAR;
            }
        }
        if constexpr (ALIGN_EPI) { if (wr == 0) PG8_BAR; }
        if constexpr (!Epi::AFTER_DRAIN) { E(acc, cur, wr, wc, fr, fq); S.done(cur); }
        if (!has_next) break;
#pragma unroll
        for (int a = 0; a < 2; ++a)
#pragma unroll
            for (int b = 0; b < 2; ++b)
#pragma unroll
                for (int m = 0; m < 4; ++m)
#pragma unroll
                    for (int n = 0; n < 2; ++n) acc[a][b][m][n] = (f32x4){0.f, 0.f, 0.f, 0.f};
        cur = nxt; cA = nA; cB = nB; ++ui;
        if constexpr (ALIGN_EPI) { if (wr == 1) PG8_BAR; }
    }
    PG8_WAIT_V(0);
    if constexpr (!ALIGN_EPI) { if (wr == 0) PG8_BAR; }
    PG8_BAR;
    if constexpr (Epi::AFTER_DRAIN) { E.fused(acc, cur, wr, wc, fr, fq, lds, wid, lane); S.done(cur); }
#undef PG8_SA
#undef PG8_SB
#undef PG8_STAGE
#undef PG8_LDA
#undef PG8_LDB
#undef PG8_MMA
#undef PG8_WAIT_V
#undef PG8_WAIT_L
#undef PG8_BAR
#undef PG8_SCHED
}
}

#define LAS __attribute__((address_space(3)))
typedef unsigned short bf16_t;
typedef short bf16x8 __attribute__((ext_vector_type(8)));
typedef short s16x4 __attribute__((ext_vector_type(4)));
typedef float f32x4 __attribute__((ext_vector_type(4)));
typedef float f32x16 __attribute__((ext_vector_type(16)));
typedef unsigned u32x4 __attribute__((ext_vector_type(4)));
typedef unsigned u32x2 __attribute__((ext_vector_type(2)));
typedef LAS unsigned char* ldsp;

__device__ __forceinline__ float bf2f(short b) { return __uint_as_float(((unsigned)(unsigned short)b) << 16); }
__device__ __forceinline__ unsigned short f2bf(float f) { const unsigned u = __float_as_uint(f); return (unsigned short)((u + 0x7fffu + ((u >> 16) & 1u)) >> 16); }
typedef float f32x2_t __attribute__((ext_vector_type(2))); typedef __bf16 bf16x2_t __attribute__((ext_vector_type(2)));
__device__ __forceinline__ unsigned pk2(float lo, float hi) { f32x2_t v = {lo, hi}; bf16x2_t b = __builtin_convertvector(v, bf16x2_t); return __builtin_bit_cast(unsigned, b); }
__device__ __forceinline__ float silu_f(float x) { return x / (1.f + __expf(-x)); }
__device__ __forceinline__ float sigmoid_f(float x) { return 1.f / (1.f + __expf(-x)); }
__device__ __forceinline__ float gelu_f(float x) { return 0.5f * x * (1.f + erff(x * 0.70710678118654752f)); }
__device__ __forceinline__ float gelu_fast(float v) {
    const float av = fabsf(v), d = av * 0.2316418882f + 1.0f, t = __builtin_amdgcn_rcpf(d);
    float q = t * 0.5307027145f + (-0.7265760135f); q = q * t + 0.7107068705f; q = q * t + (-0.142248368f); q = q * t + 0.127414796f; q = q * t;
    const float e = __builtin_amdgcn_exp2f((v * v) * (-0.72134752044f));
    const float m = v * (q * e), r = v - m; return v < 0.f ? m : r;
}
__device__ __forceinline__ float logsigmoid_f(float x) { return fminf(x, 0.f) - log1pf(expf(-fabsf(x))); }
__device__ __forceinline__ float wave_sum(float v) {
    v += xshf<1>(v); v += xshf<2>(v); v += xshf<4>(v); v += xshf<8>(v); v += xshf<16>(v); v += xshf<32>(v);
    return v;
}
__device__ __forceinline__ bf16x8 pack8(const float* v) {
    u32x4 w; w.x = pk2(v[0], v[1]); w.y = pk2(v[2], v[3]); w.z = pk2(v[4], v[5]); w.w = pk2(v[6], v[7]);
    return __builtin_bit_cast(bf16x8, w);
}
#define MFMA32(a, b, c) __builtin_amdgcn_mfma_f32_32x32x16_bf16((a), (b), (c), 0, 0, 0)
__device__ __forceinline__ int crow(int r, int hh) { return (r & 3) + 8 * (r >> 2) + 4 * hh; }

constexpr size_t MiB = 1u << 20;
constexpr size_t WS_CTL = 0, CTL_BYTES = 65536;
constexpr size_t WS_MOD = 1 * MiB;
constexpr size_t WS_BIAS = 3 * MiB;
constexpr size_t WS_ROPE = 3 * MiB + 512 * 1024;
constexpr size_t WS_WOUT = 4 * MiB;
constexpr size_t WS_WIN = 12 * MiB;
constexpr size_t WS_XC = 46 * MiB;
constexpr size_t WS_HL = 78 * MiB;
constexpr size_t WS_CLOC = 222 * MiB;
constexpr size_t WS_P = 294 * MiB;
constexpr size_t WS_GATES = 906 * MiB;
constexpr size_t WS_WSB2 = 912 * MiB;
constexpr size_t WS_QK = 914 * MiB;
constexpr size_t WS_CPREV = 986 * MiB;
constexpr size_t WS_NLOC = 910 * MiB + 512 * 1024;
constexpr size_t WS_NPREV = 912 * MiB + 512 * 1024;
constexpr size_t WS_SCL = 913 * MiB + 768 * 1024;
constexpr size_t WS_GARR = 3 * MiB + 640 * 1024;
constexpr size_t WS_STATS = 1022 * MiB;
constexpr size_t WS_END = 1023 * MiB;

constexpr int LDS_BYTES = 147456;
constexpr int LDS_SLOT = LDS_BYTES - 64;

struct Args {
    const float *x, *c, *ctx, *c_ctx, *w_mod, *b_mod, *w_in, *b_in, *conv_w, *conv_b, *ml_g, *lq1, *lk1, *lq2, *lk2, *da_g, *sg_g, *sg_b, *w_s, *b_s, *w_out, *ln_g, *ln_b;
    float* out; unsigned char* ws;
};


typedef const __attribute__((address_space(4))) struct Args* kargp_t;
#define KARGS() ({ kargp_t p_ = (kargp_t)__builtin_amdgcn_kernarg_segment_ptr(); asm volatile("" : "+s"(p_)); p_; })
__device__ __forceinline__ int fresh_tid() { int t = threadIdx.x; asm volatile("" : "+v"(t)); return t; }

__device__ __forceinline__ int win_orig_col(int n) { return n < 1280 ? n : (n < 4096 ? n + 16 : (n < 4112 ? n - 4096 + 1280 : -1)); }

__device__ __forceinline__ void transpose_item(const float* W, int ldw, bf16_t* WT, int k0, int n0, bool is_win, LAS float* scr, int lane) {
    const int np = n0 + (lane & 31); const int oc = is_win ? win_orig_col(np) : np;
#pragma unroll 8
    for (int i = 0; i < 32; ++i) { const int kk = 2 * i + (lane >> 5); scr[kk * 33 + (lane & 31)] = (oc >= 0) ? W[(size_t)(k0 + kk) * ldw + oc] : 0.f; }
    asm volatile("s_waitcnt lgkmcnt(0)" ::: "memory");
    const int c = lane & 7;
#pragma unroll
    for (int j = 0; j < 4; ++j) { const int n = (lane >> 3) + 8 * j; const LAS float* s = scr + (8 * c) * 33 + n;
        u32x4 o; o.x = pk2(s[0 * 33], s[1 * 33]); o.y = pk2(s[2 * 33], s[3 * 33]); o.z = pk2(s[4 * 33], s[5 * 33]); o.w = pk2(s[6 * 33], s[7 * 33]);
        *(u32x4*)(WT + (size_t)(n0 + n) * 1024 + k0 + 8 * c) = o; }
    asm volatile("s_waitcnt lgkmcnt(0)" ::: "memory");
}

__device__ __forceinline__ void prologue(ldsp lds, int G) {
    const kargp_t ap = KARGS();
    const int tid = fresh_tid(), lane = tid & 63, w = tid >> 6;
    const int gw = blockIdx.x * 8 + w, NGW = G * 8;
    bf16_t* WIN = (bf16_t*)(ap->ws + WS_WIN); bf16_t* WOUT = (bf16_t*)(ap->ws + WS_WOUT);
    LAS float* scr = (LAS float*)(lds + w * 8448);
    for (int it = gw; it < 8704 + 2048; it += NGW) {
        if (it < 8704) { const int l = it / 2176, r = it % 2176, kb = r / 136, nb = r % 136;
            transpose_item(ap->w_in + (size_t)l * 1024 * NINR, NINR, WIN + (size_t)l * NIN * 1024, kb * 64, nb * 32, true, scr, lane); }
        else { const int r2 = it - 8704, l = r2 / 512, r = r2 % 512, kb = r / 32, nb = r % 32;
            transpose_item(ap->w_out + (size_t)l * 1024 * 1024, 1024, WOUT + (size_t)l * 1024 * 1024, kb * 64, nb * 32, false, scr, lane); }
    }
    const int gt = blockIdx.x * 512 + tid, NGT = G * 512;
    float* BIAS = (float*)(ap->ws + WS_BIAS); float* ROPE = (float*)(ap->ws + WS_ROPE); bf16_t* WSB = (bf16_t*)(ap->ws + WS_WSB2);
    for (int i = gt; i < DEPTH * NIN; i += NGT) { const int l = i / NIN, n = i % NIN, oc = win_orig_col(n); BIAS[i] = oc >= 0 ? ap->b_in[l * NINR + oc] : 0.f; }
    for (int i = gt; i < DEPTH * 4 * 128 * 128; i += NGT) WSB[i] = f2bf(ap->w_s[i]);
    for (int i = gt; i < 96 * 16; i += NGT) { const int p = i >> 4, f = i & 15; const float pos = (float)(p < 32 ? p : p - 32);
        const float inv = powf(10000.f, -(float)f / 16.f); const float ang = pos * inv; ROPE[2 * i] = cosf(ang); ROPE[2 * i + 1] = sinf(ang); }
    __syncthreads();
    float* MOD = (float*)(ap->ws + WS_MOD);
    LAS float* SC = (LAS float*)lds;
    LAS float* RED = (LAS float*)(lds + 33 * 1024 * 4);
    bool table = false;
    for (int item = blockIdx.x; item < DEPTH * 48; item += G) {
        if (!table) { for (int i = tid; i < 33 * 1024; i += 512) { const float v = (i < 32 * 1024) ? ap->c[i] : ap->c_ctx[i - 32 * 1024]; SC[i] = silu_f(v); } table = true; }
        __syncthreads();
        const int l = item / 48, j0 = (item % 48) * 64;
        const float* wm = ap->w_mod + (size_t)l * 1024 * 3072 + j0 + lane;
        float acc[33];
#pragma unroll
        for (int r = 0; r < 33; ++r) acc[r] = 0.f;
#pragma unroll 4
        for (int k = w * 128; k < w * 128 + 128; k += 4) {
            const float w0 = wm[(size_t)k * 3072], w1 = wm[(size_t)(k + 1) * 3072], w2 = wm[(size_t)(k + 2) * 3072], w3 = wm[(size_t)(k + 3) * 3072];
#pragma unroll
            for (int r = 0; r < 33; ++r) { const f32x4 s = *(const LAS f32x4*)(SC + r * 1024 + k); acc[r] += (s[0] * w0 + s[1] * w1) + (s[2] * w2 + s[3] * w3); }
        }
        for (int ww = 0; ww < 8; ++ww) {
            if (w == ww) {
#pragma unroll
                for (int r = 0; r < 33; ++r) { if (ww == 0) RED[r * 64 + lane] = acc[r]; else RED[r * 64 + lane] += acc[r]; }
            }
            __syncthreads();
        }
        for (int i = tid; i < 33 * 64; i += 512) { const int r = i >> 6, j = i & 63; MOD[((size_t)l * 33 + r) * 3072 + j0 + j] = RED[i] + ap->b_mod[l * 3072 + j0 + j]; }
        __syncthreads();
    }
}

__device__ __forceinline__ void rowpass(int l, int G) {
    const kargp_t ap = KARGS();
    const int tid = fresh_tid(), lane = tid & 63, w = tid >> 6;
    const int gw = blockIdx.x * 8 + w, NGW = G * 8;
    const int nrows = (l == DEPTH) ? ML : MTOT;
    float* XC = (float*)(ap->ws + WS_XC); bf16_t* HL = (bf16_t*)(ap->ws + WS_HL); const float* MOD = (const float*)(ap->ws + WS_MOD);
#pragma unroll 4
    for (int m = gw; m < nrows; m += NGW) {
        const bool lat = m < ML;
        const float* src = (l == 0) ? (lat ? ap->x + (size_t)m * DM : ap->ctx + (size_t)(m - ML) * DM) : (lat ? ap->out + (size_t)m * DM : XC + (size_t)(m - ML) * DM);
        f32x4 v[4];
#pragma unroll
        for (int j = 0; j < 4; ++j) v[j] = __builtin_nontemporal_load((const f32x4*)(src + 4 * lane + 256 * j));
        if (l > 0) {
            float s = 0.f;
#pragma unroll
            for (int j = 0; j < 4; ++j) s += (v[j][0] + v[j][1]) + (v[j][2] + v[j][3]);
            const float mean = wave_sum(s) * (1.f / DM); float s2 = 0.f;
#pragma unroll
            for (int j = 0; j < 4; ++j) { v[j] = v[j] - mean; s2 += (v[j][0] * v[j][0] + v[j][1] * v[j][1]) + (v[j][2] * v[j][2] + v[j][3] * v[j][3]); }
            const float rstd = 1.f / sqrtf(wave_sum(s2) * (1.f / DM) + LN_EPS);
            float* dst = lat ? ap->out + (size_t)m * DM : XC + (size_t)(m - ML) * DM;
            if (l < DEPTH && lane == 0) { float* st = (float*)(ap->ws + WS_STATS) + (size_t)m * 2; st[0] = mean; st[1] = rstd; }
#pragma unroll
            for (int j = 0; j < 4; ++j) { const f32x4 g = *(const f32x4*)(ap->ln_g + (l - 1) * DM + 4 * lane + 256 * j), bb = *(const f32x4*)(ap->ln_b + (l - 1) * DM + 4 * lane + 256 * j);
                v[j] = v[j] * rstd * g + bb; if (l == DEPTH) *(f32x4*)(dst + 4 * lane + 256 * j) = v[j]; }
        }
        if (l < DEPTH) {
            float s = 0.f;
#pragma unroll
            for (int j = 0; j < 4; ++j) s += (v[j][0] + v[j][1]) + (v[j][2] + v[j][3]);
            const float mean = wave_sum(s) * (1.f / DM); float s2 = 0.f;
#pragma unroll
            for (int j = 0; j < 4; ++j) { v[j] = v[j] - mean; s2 += (v[j][0] * v[j][0] + v[j][1] * v[j][1]) + (v[j][2] * v[j][2] + v[j][3] * v[j][3]); }
            const float rstd = 1.f / sqrtf(wave_sum(s2) * (1.f / DM) + LN_EPS);
            const int bidx = lat ? (m >> 11) : 32;
            const float* md = MOD + ((size_t)l * 33 + bidx) * 3072;
            bf16_t* o = HL + (size_t)m * DM;
#pragma unroll
            for (int j = 0; j < 4; ++j) { const f32x4 sh = *(const f32x4*)(md + 4 * lane + 256 * j), sc = *(const f32x4*)(md + 1024 + 4 * lane + 256 * j);
                const f32x4 h = v[j] * rstd * (sc + 1.f) + sh; u32x2 pk; pk.x = pk2(h[0], h[1]); pk.y = pk2(h[2], h[3]); *(u32x2*)(o + 4 * lane + 256 * j) = pk; }
        }
    }
}

constexpr int AT_KB = 16384, AT_BUF = 32768, AT_OB = 0, AT_OS = 65536;
__device__ __forceinline__ void at_glds16(const void* gsrc, unsigned lds_dst) { unsigned keep;
    asm volatile("s_mov_b32 %0, m0\n\ts_mov_b32 m0, %2\n\ts_nop 0\n\tglobal_load_lds_dwordx4 %1, off\n\ts_mov_b32 m0, %0" : "=&s"(keep) : "v"(gsrc), "s"(lds_dst) : "memory"); }
__device__ __forceinline__ void attn_item(ldsp lds, int l, int b, int h, int qb, bool is_ctx, float lam, float lam_init) {
    const kargp_t ap = KARGS();
    const bf16_t* __restrict__ P = (const bf16_t*)(ap->ws + WS_P); bf16_t* __restrict__ mix = (bf16_t*)(ap->ws + WS_HL); const float* __restrict__ da_g = ap->da_g + l * 128;
    const int tid = fresh_tid(), lane = tid & 63, w = __builtin_amdgcn_readfirstlane(tid >> 6), r32 = lane & 31, hh = lane >> 5;
    const int c = w >> 2, wq = w & 3;
    const int qrow0 = (is_ctx ? ML + b * CTXL : b * SEQ) + qb * 128;
    bf16x8 qf[4];
    { const bf16_t* qp = P + (size_t)(qrow0 + wq * 32 + r32) * NIN + C_DAQ + h * 128 + c * 64 + 8 * hh;
#pragma unroll
      for (int ks = 0; ks < 4; ++ks) qf[ks] = *(const bf16x8*)(qp + 16 * ks); }
    f32x16 o[4];
#pragma unroll
    for (int d = 0; d < 4; ++d)
#pragma unroll
        for (int r = 0; r < 16; ++r) o[d][r] = 0.f;
    float mrun = 0.f, lrun = 0.f;
    f32x16 negm;
#pragma unroll
    for (int r = 0; r < 16; ++r) negm[r] = 0.f;
    const int ntiles = is_ctx ? 4 : 36;
    const int drow = lane >> 4, dpc = lane & 15;
    const unsigned ldsw = (unsigned)w * 2048u;
    const int vq = (lane & 15) >> 2, vlo = ((lane >> 4) & 1) * 2 + ((lane & 3) >> 1), vhalf8 = (lane & 1) * 8, vtr_row = (4 * hh + vq) * 256;
#define AT_TILE_ROW(t) (is_ctx ? (ML + b * CTXL + (t) * 64) : ((t) < 32 ? b * SEQ + (t) * 64 : ML + b * CTXL + ((t) - 32) * 64))
#define AT_DMA(t, bufo) do { const bf16_t* rp_ = P + (size_t)(AT_TILE_ROW(t) + 8 * w + drow) * NIN + h * 128; \
        _Pragma("unroll") for (int j_ = 0; j_ < 2; ++j_) { const int rr_ = 8 * w + 4 * j_ + drow; \
            at_glds16(rp_ + (size_t)(4 * j_) * NIN + C_DAK + ((dpc ^ (rr_ & 15)) << 3), (unsigned)__builtin_amdgcn_readfirstlane((int)(lds0 + (unsigned)(bufo) + ldsw + j_ * 1024))); \
            at_glds16(rp_ + (size_t)(4 * j_) * NIN + C_DAV + ((dpc ^ ((rr_ & 3) << 2)) << 3), (unsigned)__builtin_amdgcn_readfirstlane((int)(lds0 + (unsigned)(bufo) + AT_KB + ldsw + j_ * 1024))); } } while (0)
    const unsigned lds0 = (unsigned)(size_t)lds;
    __syncthreads();
#define AT_BAR() do { __builtin_amdgcn_s_barrier(); asm volatile("" ::: "memory"); } while (0)
    AT_DMA(0, 0); AT_DMA(1, AT_BUF);
    asm volatile("s_waitcnt vmcnt(4)" ::: "memory");
    AT_BAR();
    if (c == 1) AT_BAR();
    int bo = 0, bn = 2 * AT_BUF;
    for (int t = 0; t < ntiles; ++t) {
        f32x16 p0, p1;
#pragma unroll
        for (int ks = 0; ks < 4; ++ks) {
            const bf16x8 k0 = *(const LAS bf16x8*)(lds + bo + r32 * 256 + (((c * 8 + 2 * ks + hh) ^ (r32 & 15)) << 4));
            const bf16x8 k1 = *(const LAS bf16x8*)(lds + bo + (32 + r32) * 256 + (((c * 8 + 2 * ks + hh) ^ (r32 & 15)) << 4));
            if (ks == 0) { p0 = MFMA32(k0, qf[0], negm); p1 = MFMA32(k1, qf[0], negm); }
            else { p0 = MFMA32(k0, qf[ks], p0); p1 = MFMA32(k1, qf[ks], p1); }
        }
        float tm = fmaxf(fmaxf(p0[0], p0[1]), p1[0]);
#pragma unroll
        for (int r = 1; r < 16; ++r) tm = fmaxf(fmaxf(tm, p0[r]), p1[r]);
        tm = fmaxf(tm, xshf<32>(tm));
        if (t == 0) {
            mrun = tm;
#pragma unroll
            for (int r = 0; r < 16; ++r) { p0[r] -= tm; p1[r] -= tm; negm[r] = -mrun; }
        } else if (__any(tm > 8.f)) {
            const float dl = fmaxf(tm, 0.f), alpha = __builtin_amdgcn_exp2f(-dl);
            mrun += dl; lrun *= alpha;
#pragma unroll
            for (int r = 0; r < 16; ++r) { p0[r] -= dl; p1[r] -= dl; negm[r] = -mrun; }
#pragma unroll
            for (int d = 0; d < 4; ++d)
#pragma unroll
                for (int r = 0; r < 16; ++r) o[d][r] *= alpha;
        }
        float ls = 0.f;
#pragma unroll
        for (int r = 0; r < 16; ++r) { p0[r] = __builtin_amdgcn_exp2f(p0[r]); p1[r] = __builtin_amdgcn_exp2f(p1[r]); ls += p0[r] + p1[r]; }
        lrun += ls;
        bf16x8 pw[4];
#pragma unroll
        for (int kb = 0; kb < 2; ++kb)
#pragma unroll
            for (int s = 0; s < 2; ++s) {
                float pv[8];
#pragma unroll
                for (int e = 0; e < 8; ++e) pv[e] = kb ? p1[8 * s + e] : p0[8 * s + e];
                pw[kb * 2 + s] = pack8(pv);
            }
        asm volatile("s_waitcnt vmcnt(0) lgkmcnt(0)" ::: "memory");
        AT_BAR();
        if (t + 2 < ntiles) AT_DMA(t + 2, bn);
#pragma unroll
        for (int kb = 0; kb < 2; ++kb)
#pragma unroll
            for (int s = 0; s < 2; ++s) {
#pragma unroll
                for (int d = 0; d < 4; ++d) {
                    const int off = bo + AT_KB + vtr_row + (kb * 32 + 16 * s) * 256 + (((d ^ vq) * 4 + vlo) << 4) + vhalf8;
                    const s16x4 lo = __builtin_bit_cast(s16x4, __builtin_amdgcn_ds_read_tr16_b64_v4i16((LAS s16x4*)(lds + off)));
                    const s16x4 hi = __builtin_bit_cast(s16x4, __builtin_amdgcn_ds_read_tr16_b64_v4i16((LAS s16x4*)(lds + off + 8 * 256)));
                    const bf16x8 afrag = {lo[0], lo[1], lo[2], lo[3], hi[0], hi[1], hi[2], hi[3]};
                    o[d] = MFMA32(afrag, pw[kb * 2 + s], o[d]);
                }
            }
        asm volatile("s_waitcnt lgkmcnt(0)" ::: "memory");
        AT_BAR();
        bo = (bo == 2 * AT_BUF) ? 0 : bo + AT_BUF; bn = (bn == 2 * AT_BUF) ? 0 : bn + AT_BUF;
    }
    if (c == 0) AT_BAR();
#undef AT_BAR
#undef AT_TILE_ROW
#undef AT_DMA
    { const float lt = lrun + xshf<32>(lrun); const float inv = 1.f / lt;
#pragma unroll
      for (int d = 0; d < 4; ++d)
#pragma unroll
          for (int r = 0; r < 16; ++r) o[d][r] *= inv; }
    __syncthreads();
    if (c == 1) {
#pragma unroll
        for (int d = 0; d < 4; ++d)
#pragma unroll
            for (int r = 0; r < 16; ++r) *(LAS float*)(lds + AT_OB + ((wq * 64 + d * 16 + r) * 64 + lane) * 4) = o[d][r];
    }
    __syncthreads();
    if (c == 0) {
        float ss = 0.f;
#pragma unroll
        for (int d = 0; d < 4; ++d)
#pragma unroll
            for (int r = 0; r < 16; ++r) { const float o1 = *(const LAS float*)(lds + AT_OB + ((wq * 64 + d * 16 + r) * 64 + lane) * 4); const float v = o[d][r] - lam * o1; o[d][r] = v; ss += v * v; }
        ss += xshf<32>(ss);
        const float rs = rsqrtf(ss * (1.f / 128.f) + LN_EPS) * (1.f - lam_init);
#pragma unroll
        for (int d = 0; d < 4; ++d)
#pragma unroll
            for (int r = 0; r < 16; ++r) *(LAS float*)(lds + AT_OS + ((wq * 32 + r32) * 132 + d * 32 + crow(r, hh)) * 4) = o[d][r] * rs;
    }
    __syncthreads();
    if (c == 0) {
#pragma unroll 2
        for (int it = 0; it < 8; ++it) {
            const int id = it * 64 + lane, row = id >> 4, ch = id & 15;
            const f32x4 a0 = *(const LAS f32x4*)(lds + AT_OS + ((wq * 32 + row) * 132 + ch * 8) * 4), a1 = *(const LAS f32x4*)(lds + AT_OS + ((wq * 32 + row) * 132 + ch * 8 + 4) * 4);
            const size_t grow = (size_t)(qrow0 + wq * 32 + row);
            const bf16x8 z = *(const bf16x8*)(P + grow * NIN + C_DAZ + h * 128 + ch * 8);
            const f32x4 g0 = *(const f32x4*)(da_g + ch * 8), g1 = *(const f32x4*)(da_g + ch * 8 + 4);
            float y[8];
#pragma unroll
            for (int e = 0; e < 4; ++e) { y[e] = a0[e] * g0[e] * silu_f(bf2f(z[e])); y[4 + e] = a1[e] * g1[e] * silu_f(bf2f(z[4 + e])); }
            *(bf16x8*)(mix + grow * DM + 256 + h * 128 + ch * 8) = pack8(y);
        }
    }
}

constexpr int SG_V = 0, SG_YS = 73728;
__device__ __forceinline__ void sgu_item(ldsp lds, int l, int row0) {
    const kargp_t ap = KARGS();
    const bf16_t* __restrict__ P = (const bf16_t*)(ap->ws + WS_P); bf16_t* __restrict__ mix = (bf16_t*)(ap->ws + WS_HL);
    const bf16_t* __restrict__ wsb = (const bf16_t*)(ap->ws + WS_WSB2) + (size_t)l * 4 * 128 * 128;
    const float* __restrict__ sg_g = ap->sg_g + l * 256; const float* __restrict__ sg_b = ap->sg_b + l * 256; const float* __restrict__ b_s = ap->b_s + l * 4 * 128;
    const int tid = fresh_tid(), lane = tid & 63, w = __builtin_amdgcn_readfirstlane(tid >> 6), r32 = lane & 31, hh = lane >> 5;
    {
        const int tok = tid >> 2, part = tid & 3;
        const bf16_t* rp = P + (size_t)(row0 + tok) * NIN + C_SGV + part * 64;
        float x[64]; float s = 0.f;
#pragma unroll
        for (int i = 0; i < 8; ++i) { const bf16x8 v = *(const bf16x8*)(rp + 8 * i);
#pragma unroll
            for (int e = 0; e < 8; ++e) { x[8 * i + e] = gelu_fast(bf2f(v[e])); s += x[8 * i + e]; } }
        s += xshf<1>(s); s += xshf<2>(s);
        const float mean = s * (1.f / 256.f); float s2 = 0.f;
#pragma unroll
        for (int e = 0; e < 64; ++e) { x[e] -= mean; s2 += x[e] * x[e]; }
        s2 += xshf<1>(s2); s2 += xshf<2>(s2);
        const float rstd = rsqrtf(s2 * (1.f / 256.f) + LN_EPS);
#pragma unroll
        for (int i = 0; i < 8; ++i) {
            const f32x4 g0 = *(const f32x4*)(sg_g + part * 64 + 8 * i), g1 = *(const f32x4*)(sg_g + part * 64 + 8 * i + 4), b0 = *(const f32x4*)(sg_b + part * 64 + 8 * i), b1 = *(const f32x4*)(sg_b + part * 64 + 8 * i + 4);
            float y[8];
#pragma unroll
            for (int e = 0; e < 4; ++e) { y[e] = x[8 * i + e] * rstd * g0[e] + b0[e]; y[4 + e] = x[8 * i + 4 + e] * rstd * g1[e] + b1[e]; }
            *(LAS bf16x8*)(lds + SG_V + tok * 576 + (part * 64 + 8 * i) * 2) = pack8(y);
        }
    }
    __syncthreads();
    const int pblk = w >> 1, dblk = w & 1;
    const int vtr = (8 * hh + ((lane & 15) >> 2)) * 576 + (dblk * 32 + 16 * ((lane >> 4) & 1) + 4 * (lane & 3)) * 2;
    for (int g = 0; g < 4; ++g) {
        const bf16_t* rq0 = P + (size_t)(row0 + (tid >> 3)) * NIN + g * 64 + (tid & 7) * 8; const bf16_t* rq1 = rq0 + (size_t)64 * NIN;
        const bf16x8 pu0 = *(const bf16x8*)(rq0 + C_SGU), pz0 = *(const bf16x8*)(rq0 + C_SGZ), pu1 = *(const bf16x8*)(rq1 + C_SGU), pz1 = *(const bf16x8*)(rq1 + C_SGZ);
        f32x16 acc;
#pragma unroll
        for (int r = 0; r < 16; ++r) acc[r] = 0.f;
        const bf16_t* wp = wsb + (size_t)g * 128 * 128 + (size_t)(pblk * 32 + r32) * 128 + 8 * hh;
#pragma unroll
        for (int ks = 0; ks < 8; ++ks) {
            const bf16x8 af = *(const bf16x8*)(wp + 16 * ks);
            const int off = SG_V + vtr + (16 * ks) * 576 + g * 128;
            const s16x4 lo = __builtin_bit_cast(s16x4, __builtin_amdgcn_ds_read_tr16_b64_v4i16((LAS s16x4*)(lds + off)));
            const s16x4 hi = __builtin_bit_cast(s16x4, __builtin_amdgcn_ds_read_tr16_b64_v4i16((LAS s16x4*)(lds + off + 4 * 576)));
            const bf16x8 bfr = {lo[0], lo[1], lo[2], lo[3], hi[0], hi[1], hi[2], hi[3]};
            acc = MFMA32(af, bfr, acc);
        }
#pragma unroll
        for (int r = 0; r < 16; ++r) { const int p = pblk * 32 + crow(r, hh); *(LAS float*)(lds + SG_YS + (p * 68 + dblk * 32 + r32) * 4) = acc[r] + b_s[g * 128 + p]; }
        __syncthreads();
#pragma unroll
        for (int i = 0; i < 2; ++i) {
            const int id = tid + 512 * i, p = id >> 3, ch = id & 7;
            const f32x4 v0 = *(const LAS f32x4*)(lds + SG_YS + (p * 68 + ch * 8) * 4), v1 = *(const LAS f32x4*)(lds + SG_YS + (p * 68 + ch * 8 + 4) * 4);
            const bf16x8 u = i ? pu1 : pu0, z = i ? pz1 : pz0;
            float y[8];
#pragma unroll
            for (int e = 0; e < 4; ++e) { y[e] = gelu_fast(bf2f(u[e])) * v0[e] * silu_f(bf2f(z[e])); y[4 + e] = gelu_fast(bf2f(u[4 + e])) * v1[e] * silu_f(bf2f(z[4 + e])); }
            *(bf16x8*)(mix + (size_t)(row0 + p) * DM + 768 + g * 64 + ch * 8) = pack8(y);
        }
        __syncthreads();
    }
}

constexpr int MQ_QS = 0, MQ_KS = 18432, MQ_HS = 80896, MQ_SM = 115712;
constexpr int MA_V = 36864, MA_KW = 61440;
constexpr int MC_V = 36864, MC_CB0 = 61440, MC_CB1 = 70656;
__device__ __forceinline__ int ml_rec(int pair, int dir, int cid) { return (pair * 2 + dir) * 18 + cid; }

__device__ __forceinline__ void mlstm_A(ldsp lds, int l, int pair, int cid) {
    const kargp_t ap = KARGS();
    const bf16_t* __restrict__ P = (const bf16_t*)(ap->ws + WS_P); bf16_t* __restrict__ QK = (bf16_t*)(ap->ws + WS_QK);
    const float* __restrict__ GATES = (const float*)(ap->ws + WS_GATES);
    float* __restrict__ CLOC = (float*)(ap->ws + WS_CLOC); float* __restrict__ NLOC = (float*)(ap->ws + WS_NLOC); float* __restrict__ SCL = (float*)(ap->ws + WS_SCL);
    const float* __restrict__ conv_w = ap->conv_w + (size_t)l * 3 * 512; const float* __restrict__ conv_b = ap->conv_b + l * 512;
    const int tid = fresh_tid(), lane = tid & 63, w = __builtin_amdgcn_readfirstlane(tid >> 6), r32 = lane & 31, hh = lane >> 5;
    const int b = pair >> 2, h = pair & 3;
    const bool isctx = cid < 2; const int cpos = isctx ? cid : cid - 2, L = isctx ? CTXL : SEQ, c0 = cpos * 128;
    const size_t seqrow = isctx ? (size_t)(ML + b * CTXL) : (size_t)b * SEQ;
    LAS float* GI = (LAS float*)(lds + MQ_SM); LAS float* GF = GI + 256; LAS float* WG2 = GI + 512;
    __syncthreads();
#pragma unroll
    for (int i = 0; i < 2; ++i) {
        const int id = tid + 512 * i, r = id >> 3, ch = id & 7, tt = c0 + r;
        const bf16_t* rp = P + (seqrow + tt) * NIN;
#pragma unroll
        for (int which = 0; which < 2; ++which) {
            const int colP = (which ? C_MLK : C_MLQ) + h * 64 + ch * 8, colW = (which ? 256 : 0) + h * 64 + ch * 8;
            const bf16x8 x0 = *(const bf16x8*)(rp + colP);
            bf16x8 xm = {0, 0, 0, 0, 0, 0, 0, 0}, xp = {0, 0, 0, 0, 0, 0, 0, 0};
            if (tt > 0) xm = *(const bf16x8*)(rp - NIN + colP);
            if (tt < L - 1) xp = *(const bf16x8*)(rp + NIN + colP);
            const f32x4 w0a = *(const f32x4*)(conv_w + colW), w0b = *(const f32x4*)(conv_w + colW + 4), w1a = *(const f32x4*)(conv_w + 512 + colW), w1b = *(const f32x4*)(conv_w + 512 + colW + 4);
            const f32x4 w2a = *(const f32x4*)(conv_w + 1024 + colW), w2b = *(const f32x4*)(conv_w + 1024 + colW + 4), cba = *(const f32x4*)(conv_b + colW), cbb = *(const f32x4*)(conv_b + colW + 4);
            float y[8];
#pragma unroll
            for (int e = 0; e < 8; ++e) {
                const float c0w = e < 4 ? w0a[e & 3] : w0b[e & 3], c1w = e < 4 ? w1a[e & 3] : w1b[e & 3], c2w = e < 4 ? w2a[e & 3] : w2b[e & 3], cbw = e < 4 ? cba[e & 3] : cbb[e & 3];
                float v = c0w * bf2f(xm[e]) + c1w * bf2f(x0[e]) + c2w * bf2f(xp[e]) + cbw;
                v = silu_f(v); if (which) v *= 0.125f; y[e] = v;
            }
            const bf16x8 pk = pack8(y);
            *(bf16x8*)(QK + (seqrow + tt) * 512 + which * 256 + h * 64 + ch * 8) = pk;
            if (which) *(LAS bf16x8*)(lds + MQ_KS + r * 144 + ch * 16) = pk;
        }
    }
#pragma unroll
    for (int i = 0; i < 2; ++i) {
        const int id = tid + 512 * i, r = id >> 3, ch = id & 7;
        *(LAS u32x4*)(lds + MA_V + r * 192 + ch * 16) = *(const u32x4*)(P + (seqrow + c0 + r) * NIN + C_MLV + h * 64 + ch * 8);
    }
    if (tid < 256) { const int dir = tid >> 7, s = tid & 127; const float* gp = GATES + (seqrow + c0 + s) * 16 + dir * 8 + h; GI[tid] = gp[0]; GF[tid] = logsigmoid_f(gp[4]); }
    __syncthreads();
    if (w < 2) {
        const int dir = w;
        const float f0 = GF[dir * 128 + 2 * lane], f1 = GF[dir * 128 + 2 * lane + 1], i0 = GI[dir * 128 + 2 * lane], i1 = GI[dir * 128 + 2 * lane + 1];
        const float s1 = f0 + f1; float x = s1;
#pragma unroll
        for (int off = 1; off < 64; off <<= 1) { const float y = lshf(x, lane - off); if (lane >= off) x += y; }
        const float tot = lshf(x, 63), ex = x - s1;
        const float b0 = dir ? tot - ex : ex + f0, b1 = dir ? tot - (ex + f0) : ex + s1;
        const float a0 = i0 - b0, a1 = i1 - b1;
        float sc_ = fmaxf(a0, a1), g0, g1;
        if (dir == 0) {
#pragma unroll
            for (int off = 1; off < 64; off <<= 1) { const float y = lshf(sc_, lane - off); if (lane >= off) sc_ = fmaxf(sc_, y); }
            float pe = lshf(sc_, lane - 1); if (lane == 0) pe = -3.0e38f;
            g0 = fmaxf(pe, a0); g1 = sc_;
        } else {
#pragma unroll
            for (int off = 1; off < 64; off <<= 1) { const float y = lshf(sc_, lane + off); if (lane + off < 64) sc_ = fmaxf(sc_, y); }
            float pe = lshf(sc_, lane + 1); if (lane == 63) pe = -3.0e38f;
            g1 = fmaxf(pe, a1); g0 = sc_;
        }
        const float mx = lshf(sc_, dir == 0 ? 63 : 0);
        { float* gp = (float*)(const_cast<bf16_t*>(P) + (seqrow + c0 + 2 * lane) * NIN + 4096) + (h * 2 + dir) * 4;
          *(f32x4*)gp = (f32x4){a0, b0, g0, 0.f}; *(f32x4*)(gp + NIN / 2) = (f32x4){a1, b1, g1, 0.f}; }
        WG2[dir * 128 + 2 * lane] = __expf(a0 - mx); WG2[dir * 128 + 2 * lane + 1] = __expf(a1 - mx);
        if (lane == 0) { float* sc = SCL + (size_t)ml_rec(pair, dir, cid) * 4; sc[0] = tot; sc[1] = tot + mx; }
    }
    __syncthreads();
#pragma unroll
    for (int i = 0; i < 2; ++i) {
        const int id = tid + 512 * i, r = id >> 3, ch = id & 7;
        const bf16x8 kv = *(const LAS bf16x8*)(lds + MQ_KS + r * 144 + ch * 16);
#pragma unroll
        for (int dir = 0; dir < 2; ++dir) {
            const float wg = WG2[dir * 128 + r]; float y[8];
#pragma unroll
            for (int e = 0; e < 8; ++e) y[e] = bf2f(kv[e]) * wg;
            *(LAS bf16x8*)(lds + MA_KW + dir * 24576 + r * 192 + ch * 16) = pack8(y);
        }
    }
    __syncthreads();
    {
        const int dir = w >> 2, vb = (w >> 1) & 1, kb = w & 1; const int rec = ml_rec(pair, dir, cid);
        const int trb = (8 * hh + ((lane & 15) >> 2)) * 192 + (16 * ((lane >> 4) & 1) + 4 * (lane & 3)) * 2;
        const short one = (r32 == 0) ? (short)0x3F80 : (short)0;
        const bf16x8 ones = {one, one, one, one, one, one, one, one};
        f32x16 cl, nl;
#pragma unroll
        for (int r = 0; r < 16; ++r) { cl[r] = 0.f; nl[r] = 0.f; }
#pragma unroll
        for (int ks = 0; ks < 8; ++ks) {
            const int ao = MA_V + trb + (16 * ks) * 192 + vb * 64, bo_ = MA_KW + dir * 24576 + trb + (16 * ks) * 192 + kb * 64;
            const s16x4 al = __builtin_bit_cast(s16x4, __builtin_amdgcn_ds_read_tr16_b64_v4i16((LAS s16x4*)(lds + ao))), ah = __builtin_bit_cast(s16x4, __builtin_amdgcn_ds_read_tr16_b64_v4i16((LAS s16x4*)(lds + ao + 4 * 192)));
            const s16x4 bl = __builtin_bit_cast(s16x4, __builtin_amdgcn_ds_read_tr16_b64_v4i16((LAS s16x4*)(lds + bo_))), bh = __builtin_bit_cast(s16x4, __builtin_amdgcn_ds_read_tr16_b64_v4i16((LAS s16x4*)(lds + bo_ + 4 * 192)));
            const bf16x8 af = {al[0], al[1], al[2], al[3], ah[0], ah[1], ah[2], ah[3]}, bfr = {bl[0], bl[1], bl[2], bl[3], bh[0], bh[1], bh[2], bh[3]};
            cl = MFMA32(af, bfr, cl);
            if (vb == 0) nl = MFMA32(ones, bfr, nl);
        }
        float* cp = CLOC + (size_t)rec * 4096;
#pragma unroll
        for (int r = 0; r < 16; ++r) cp[(vb * 32 + crow(r, hh)) * 64 + kb * 32 + r32] = cl[r];
        if (vb == 0 && hh == 0) NLOC[(size_t)rec * 64 + kb * 32 + r32] = nl[0];
    }
}

__device__ __forceinline__ void mlstm_B(int l, int pair, int dir) {
    const kargp_t ap = KARGS();
    const float* __restrict__ CLOC = (const float*)(ap->ws + WS_CLOC); const float* __restrict__ NLOC = (const float*)(ap->ws + WS_NLOC);
    float* __restrict__ SCL = (float*)(ap->ws + WS_SCL); bf16_t* __restrict__ CPREV = (bf16_t*)(ap->ws + WS_CPREV); float* __restrict__ NPREV = (float*)(ap->ws + WS_NPREV);
    const int tid = fresh_tid();
    float c[8]; float n = 0.f, m = 0.f;
#pragma unroll
    for (int e = 0; e < 8; ++e) c[e] = 0.f;
    for (int s0 = 0; s0 < 18; s0 += 6) {
        f32x4 l0[6], l1[6]; float nl[6], bend[6], mloc[6]; int rec[6];
#pragma unroll
        for (int u = 0; u < 6; ++u) {
            const int step = s0 + u; const bool isctx = step < 2; const int cidx = isctx ? step : step - 2, nch = isctx ? 2 : 16;
            const int cpos = (dir == 0) ? cidx : nch - 1 - cidx, cid = isctx ? cpos : 2 + cpos;
            rec[u] = ml_rec(pair, dir, cid);
            l0[u] = *(const f32x4*)(CLOC + (size_t)rec[u] * 4096 + tid * 8); l1[u] = *(const f32x4*)(CLOC + (size_t)rec[u] * 4096 + tid * 8 + 4);
            nl[u] = (tid < 64) ? NLOC[(size_t)rec[u] * 64 + tid] : 0.f;
            bend[u] = SCL[(size_t)rec[u] * 4]; mloc[u] = SCL[(size_t)rec[u] * 4 + 1];
        }
#pragma unroll
        for (int u = 0; u < 6; ++u) {
            *(bf16x8*)(CPREV + (size_t)rec[u] * 4096 + tid * 8) = pack8(c);
            if (tid < 64) NPREV[(size_t)rec[u] * 64 + tid] = n;
            if (tid == 0) SCL[(size_t)rec[u] * 4 + 2] = m;
            const float m_new = fmaxf(bend[u] + m, mloc[u]), fa = __expf(bend[u] + m - m_new), fs = __expf(mloc[u] - m_new);
#pragma unroll
            for (int e = 0; e < 4; ++e) { c[e] = fa * c[e] + fs * l0[u][e]; c[4 + e] = fa * c[4 + e] + fs * l1[u][e]; }
            n = fa * n + fs * nl[u]; m = m_new;
        }
    }
}

__device__ __forceinline__ void mlstm_C(ldsp lds, int l, int pair, int cid) {
    const kargp_t ap = KARGS();
    const bf16_t* __restrict__ P = (const bf16_t*)(ap->ws + WS_P); bf16_t* __restrict__ mix = (bf16_t*)(ap->ws + WS_HL); const bf16_t* __restrict__ QK = (const bf16_t*)(ap->ws + WS_QK);
    const float* __restrict__ SCL = (const float*)(ap->ws + WS_SCL); const bf16_t* __restrict__ CPREV = (const bf16_t*)(ap->ws + WS_CPREV); const float* __restrict__ NPREV = (const float*)(ap->ws + WS_NPREV);
    const float* __restrict__ ml_g = ap->ml_g + l * 256;
    const int tid = fresh_tid(), lane = tid & 63, w = __builtin_amdgcn_readfirstlane(tid >> 6), r32 = lane & 31, hh = lane >> 5;
    const int b = pair >> 2, h = pair & 3;
    const bool isctx = cid < 2; const int cpos = isctx ? cid : cid - 2, c0 = cpos * 128;
    const size_t seqrow = isctx ? (size_t)(ML + b * CTXL) : (size_t)b * SEQ;
    LAS float* GA = (LAS float*)(lds + MQ_SM);
    LAS float* GB = GA + 256;
    LAS float* GM = GA + 512;
    LAS float* NV = GA + 768;
    const int rec0 = ml_rec(pair, 0, cid), rec1 = ml_rec(pair, 1, cid);
    const float mp0 = SCL[(size_t)rec0 * 4 + 2], mp1 = SCL[(size_t)rec1 * 4 + 2];
    const bf16_t* rpe = P + (seqrow + c0 + (tid >> 2)) * NIN + h * 64 + (tid & 3) * 16;
    const bf16x8 o0 = *(const bf16x8*)(rpe + C_MLO), o1 = *(const bf16x8*)(rpe + C_MLO + 8), z0 = *(const bf16x8*)(rpe + C_MLZ), z1 = *(const bf16x8*)(rpe + C_MLZ + 8);
    __syncthreads();
#pragma unroll
    for (int i = 0; i < 2; ++i) {
        const int id = tid + 512 * i, r = id >> 3, ch = id & 7;
        const bf16_t* rp = QK + (seqrow + c0 + r) * 512 + h * 64 + ch * 8;
        *(LAS u32x4*)(lds + MQ_QS + r * 144 + ch * 16) = *(const u32x4*)rp;
        *(LAS u32x4*)(lds + MQ_KS + r * 144 + ch * 16) = *(const u32x4*)(rp + 256);
    }
#pragma unroll
    for (int i = 0; i < 2; ++i) {
        const int id = tid + 512 * i, r = id >> 3, ch = id & 7;
        *(LAS u32x4*)(lds + MC_V + r * 192 + ch * 16) = *(const u32x4*)(P + (seqrow + c0 + r) * NIN + C_MLV + h * 64 + ch * 8);
    }
    *(LAS u32x4*)(lds + MC_CB0 + (tid >> 3) * 144 + (tid & 7) * 16) = *(const u32x4*)(CPREV + (size_t)rec0 * 4096 + tid * 8);
    *(LAS u32x4*)(lds + MC_CB1 + (tid >> 3) * 144 + (tid & 7) * 16) = *(const u32x4*)(CPREV + (size_t)rec1 * 4096 + tid * 8);
    if (tid < 128) NV[tid] = NPREV[(size_t)(tid < 64 ? rec0 : rec1) * 64 + (tid & 63)];
    if (tid < 256) { const int dir = tid >> 7, tok = tid & 127;
        const f32x4 g = *(const f32x4*)((const float*)(P + (seqrow + c0 + tok) * NIN + 4096) + (h * 2 + dir) * 4);
        GA[tid] = g[0]; GB[tid] = g[1]; GM[tid] = g[2]; }
    __syncthreads();
    {
        const int jb = w & 3, vh = w >> 2, j = jb * 32 + r32;
        bf16x8 qf[4];
#pragma unroll
        for (int ks = 0; ks < 4; ++ks) qf[ks] = *(const LAS bf16x8*)(lds + MQ_QS + j * 144 + (16 * ks + 8 * hh) * 2);
        f32x16 tot;
#pragma unroll
        for (int r = 0; r < 16; ++r) tot[r] = 0.f;
#pragma unroll
        for (int dir = 0; dir < 2; ++dir) {
            const float m_state = dir ? mp1 : mp0;
            const float e_j = fmaxf(m_state, GM[dir * 128 + j]), b_j = GB[dir * 128 + j];
            f32x16 acc;
#pragma unroll
            for (int r = 0; r < 16; ++r) acc[r] = 0.f;
            float dsum = 0.f;
            const int sb_lo = dir ? jb : 0, sb_hi = dir ? 3 : jb;
            for (int sb = sb_lo; sb <= sb_hi; ++sb) {
                f32x16 st;
#pragma unroll
                for (int r = 0; r < 16; ++r) st[r] = 0.f;
#pragma unroll
                for (int ks = 0; ks < 4; ++ks) { const bf16x8 kf = *(const LAS bf16x8*)(lds + MQ_KS + (sb * 32 + r32) * 144 + (16 * ks + 8 * hh) * 2); st = MFMA32(kf, qf[ks], st); }
#pragma unroll
                for (int r = 0; r < 16; ++r) { const int s = sb * 32 + crow(r, hh); const float a_s = GA[dir * 128 + s];
                    const bool ok = dir ? (s >= j) : (s <= j);
                    const float val = ok ? st[r] * __expf(fminf(a_s - e_j, 0.f)) : 0.f; st[r] = val; dsum += val; }
#pragma unroll
                for (int s2 = 0; s2 < 2; ++s2) {
                    float pv[8];
#pragma unroll
                    for (int e = 0; e < 8; ++e) pv[e] = st[8 * s2 + e];
                    const bf16x8 bfrag = pack8(pv);
                    const int off = MC_V + (sb * 32 + 16 * s2 + 4 * hh + ((lane & 15) >> 2)) * 192 + (vh * 32 + 16 * ((lane >> 4) & 1) + 4 * (lane & 3)) * 2;
                    const s16x4 lo = __builtin_bit_cast(s16x4, __builtin_amdgcn_ds_read_tr16_b64_v4i16((LAS s16x4*)(lds + off))), hi = __builtin_bit_cast(s16x4, __builtin_amdgcn_ds_read_tr16_b64_v4i16((LAS s16x4*)(lds + off + 8 * 192)));
                    const bf16x8 afrag = {lo[0], lo[1], lo[2], lo[3], hi[0], hi[1], hi[2], hi[3]};
                    acc = MFMA32(afrag, bfrag, acc);
                }
            }
            f32x16 acc2;
#pragma unroll
            for (int r = 0; r < 16; ++r) acc2[r] = 0.f;
#pragma unroll
            for (int ks = 0; ks < 4; ++ks) { const bf16x8 cf = *(const LAS bf16x8*)(lds + (dir ? MC_CB1 : MC_CB0) + (vh * 32 + r32) * 144 + (16 * ks + 8 * hh) * 2); acc2 = MFMA32(cf, qf[ks], acc2); }
            const float w_int = __expf(m_state - e_j);
            float nq = 0.f;
#pragma unroll
            for (int ks = 0; ks < 4; ++ks)
#pragma unroll
                for (int e = 0; e < 8; ++e) nq += bf2f(qf[ks][e]) * NV[dir * 64 + 16 * ks + 8 * hh + e];
            nq += xshf<32>(nq); dsum += xshf<32>(dsum);
            const float den = w_int * nq + dsum;
            const float inv = 1.f / fmaxf(fabsf(den), __expf(-(b_j + e_j)));
#pragma unroll
            for (int r = 0; r < 16; ++r) tot[r] += (acc[r] + w_int * acc2[r]) * inv;
        }
#pragma unroll
        for (int r = 0; r < 16; ++r) *(LAS float*)(lds + MQ_HS + (j * 68 + vh * 32 + crow(r, hh)) * 4) = tot[r];
    }
    __syncthreads();
    {
        const int j = tid >> 2, qv = tid & 3; const size_t row = seqrow + c0 + j;
        float x[16]; float s = 0.f;
#pragma unroll
        for (int q4 = 0; q4 < 4; ++q4) {
            const f32x4 hs = *(const LAS f32x4*)(lds + MQ_HS + (j * 68 + qv * 16 + q4 * 4) * 4);
#pragma unroll
            for (int e = 0; e < 4; ++e) { const int idx = q4 * 4 + e; const float og = sigmoid_f(bf2f(idx < 8 ? o0[idx & 7] : o1[idx & 7])); x[idx] = og * hs[e]; s += x[idx]; }
        }
        s += xshf<1>(s); s += xshf<2>(s);
        const float mean = s * (1.f / 64.f); float s2 = 0.f;
#pragma unroll
        for (int e = 0; e < 16; ++e) { x[e] -= mean; s2 += x[e] * x[e]; }
        s2 += xshf<1>(s2); s2 += xshf<2>(s2);
        const float rstd = rsqrtf(s2 * (1.f / 64.f) + LN_EPS);
        float y[16];
#pragma unroll
        for (int e = 0; e < 16; ++e) y[e] = x[e] * rstd * ml_g[h * 64 + qv * 16 + e] * silu_f(bf2f(e < 8 ? z0[e & 7] : z1[e & 7]));
        bf16_t* mp = mix + row * DM + h * 64 + qv * 16;
        *(bf16x8*)mp = pack8(y); *(bf16x8*)(mp + 8) = pack8(y + 8);
    }
}

typedef unsigned int gu32_unused_t;
#define XB_TMO      128
#define XB_XCNT(j)  (256  + 64 * (j))
#define XB_XSUB(j)  (1280 + 64 * (j))
#define XB_XGEN(j)  (2304 + 64 * (j))
#define XB_TOP      3328
#define XB_TOPGEN   3392
#define XCD_BAR_WORDS 3456
#define XB_SPIN_CAP (1u << 18)

__device__ __forceinline__ unsigned xb_ld(unsigned* p)              { return __hip_atomic_load(p, __ATOMIC_RELAXED, __HIP_MEMORY_SCOPE_AGENT); }
__device__ __forceinline__ unsigned xb_add(unsigned* p, unsigned v) { return __hip_atomic_fetch_add(p, v, __ATOMIC_RELAXED, __HIP_MEMORY_SCOPE_AGENT); }
__device__ __forceinline__ unsigned xb_xcc_id() { return (unsigned)__builtin_amdgcn_s_getreg((3 << 11) | 20) & 0xFu; }
#define XB_SPIN(cond, bar) do { unsigned _sp = 0; while (cond) { __builtin_amdgcn_s_sleep(1); \
    if ((++_sp & 255u) == 0u) { if (xb_ld(&(bar)[XB_TMO])) break; if (_sp > XB_SPIN_CAP) { atomicAdd(&(bar)[XB_TMO], 1u); break; } } } } while (0)

struct XcdBarrier {
    unsigned* bar; unsigned x;
    volatile LAS unsigned* st;
};

__device__ __forceinline__ XcdBarrier xcd_barrier_post(unsigned* bar, volatile LAS unsigned* st) {
    XcdBarrier b; b.bar = bar; b.x = xb_xcc_id(); b.st = st;
    if (threadIdx.x == 0) (void)xb_add(&bar[XB_XCNT(b.x)], 1u);
    return b;
}
__device__ __forceinline__ void xcd_barrier_complete(unsigned* bar, unsigned x, unsigned& nloc, unsigned& nx) {
    const unsigned G = gridDim.x * gridDim.y * gridDim.z;
    unsigned sum, cnt, mine, sp = 0u;
    for (;;) {
        sum = 0u; cnt = 0u; mine = 0u;
#pragma unroll
        for (unsigned j = 0; j < 16; ++j) { const unsigned c = xb_ld(&bar[XB_XCNT(j)]); sum += c; cnt += (c > 0u) ? 1u : 0u; mine = (j == x) ? c : mine; }
        if (sum == G) break;
        __builtin_amdgcn_s_sleep(1);
        if ((++sp & 255u) == 0u) { if (xb_ld(&bar[XB_TMO])) break; if (sp > XB_SPIN_CAP) { atomicAdd(&bar[XB_TMO], 1u); break; } }
    }
    nloc = mine > 0u ? mine : 1u; nx = cnt > 0u ? cnt : 1u;
}

__device__ __forceinline__ void xcd_barrier(const XcdBarrier& b) {
    asm volatile("s_waitcnt vmcnt(0)" ::: "memory");
    __syncthreads();
    if (threadIdx.x == 0) {
        unsigned* bar = b.bar;
        __builtin_amdgcn_s_waitcnt(0);
        unsigned nloc = b.st[0], nx = b.st[1];
        if (nloc == 0u) { xcd_barrier_complete(bar, b.x, nloc, nx); b.st[0] = nloc; b.st[1] = nx; }
        const unsigned old = xb_add(&bar[XB_XSUB(b.x)], 1u);
        const unsigned gen = old / nloc;
        if (old + 1u == (gen + 1u) * nloc) {
            __builtin_amdgcn_fence(__ATOMIC_RELEASE, "agent");
            asm volatile("s_waitcnt vmcnt(0)" ::: "memory");
            const unsigned og = xb_add(&bar[XB_TOP], 1u);
            const unsigned tg = og / nx;
            if (og + 1u == (tg + 1u) * nx) xb_add(&bar[XB_TOPGEN], 1u);
            else XB_SPIN(xb_ld(&bar[XB_TOPGEN]) == tg, bar);
            __builtin_amdgcn_fence(__ATOMIC_ACQUIRE, "agent");
            xb_add(&bar[XB_XGEN(b.x)], 1u);
            asm volatile("s_waitcnt vmcnt(0)" ::: "memory");
        } else {
            XB_SPIN(xb_ld(&bar[XB_XGEN(b.x)]) == gen, bar);
            __builtin_amdgcn_fence(__ATOMIC_ACQUIRE, "agent");
            asm volatile("s_waitcnt vmcnt(0)" ::: "memory");
        }
    }
    __syncthreads();
}

template <int SP> __device__ __forceinline__ void mixer_sub(ldsp lds, int l, int rep, float lam, float lam_init) {
    const bool need_ctx = l < DEPTH - 1;
    unsigned* ctl; { const kargp_t ap = KARGS(); ctl = (unsigned*)(ap->ws + WS_CTL) + rep * 2048; }
    const int ncc = need_ctx ? 18 : 16;
    const int n_ac = need_ctx ? 32 : 0, n_c = 16 * ncc, n_sg = need_ctx ? 72 : 64;
    const int total = SP == 0 ? 128 + 288 : (SP == 1 ? 32 : 128 + n_ac + n_c + n_sg);
    volatile LAS int* slot = (volatile LAS int*)(lds + LDS_SLOT);
    const int myx = (int)(__builtin_amdgcn_s_getreg((3 << 11) | 20) & 7u);
    for (int k = 0; k < 8; ++k) {
        const int x = (myx + k) & 7;
        unsigned* ctr = ctl + ((l * 3 + SP) * 8 + x) * 16;
        for (;;) {
            __syncthreads();
            if (threadIdx.x == 0) *slot = (int)atomicAdd(ctr, 1u);
            __syncthreads();
            int it = *slot;
            it = __builtin_amdgcn_readfirstlane(it);
            if (it >= total) break;
            if (SP == 0) {
                if (it < 128) { const int pair = x * 16 + (it >> 4); attn_item(lds, l, pair >> 2, pair & 3, it & 15, false, lam, lam_init); continue; }
                it -= 128;
                mlstm_A(lds, l, x * 16 + it / 18, it % 18);
            } else if (SP == 1) {
                mlstm_B(l, x * 16 + (it >> 1), it & 1);
            } else {
                if (it < 128) { it += 128; const int pair = x * 16 + (it >> 4); attn_item(lds, l, pair >> 2, pair & 3, it & 15, false, lam, lam_init); continue; }
                it -= 128;
                if (it < n_ac) { const int pair = x * 16 + (it >> 1); attn_item(lds, l, pair >> 2, pair & 3, it & 1, true, lam, lam_init); continue; }
                it -= n_ac;
                if (it < n_c) { mlstm_C(lds, l, x * 16 + it / ncc, (it % ncc) + (need_ctx ? 0 : 2)); continue; }
                it -= n_c;
                const int row0 = (it < 64) ? (4 * x + (it >> 4)) * SEQ + (it & 15) * 128 : ML + (4 * x + ((it - 64) >> 1)) * CTXL + ((it - 64) & 1) * 128;
                sgu_item(lds, l, row0);
            }
        }
    }
}
__device__ __forceinline__ void mixer_phase(ldsp lds, int l, const XcdBarrier& xb, int rep = 0) {
    float lam, lam_init;
    { const kargp_t ap = KARGS();
      float d1 = 0.f, d2 = 0.f;
      const float* q1 = ap->lq1 + l * 64; const float* k1 = ap->lk1 + l * 64; const float* q2 = ap->lq2 + l * 64; const float* k2 = ap->lk2 + l * 64;
      for (int i = 0; i < 64; ++i) { d1 += q1[i] * k1[i]; d2 += q2[i] * k2[i]; }
      lam_init = 0.8f - 0.6f * expf(-0.3f * (float)l);
      lam = expf(d1) - expf(d2) + lam_init; }
    mixer_sub<0>(lds, l, rep, lam, lam_init);
    xcd_barrier(xb);
    mixer_sub<1>(lds, l, rep, lam, lam_init);
    xcd_barrier(xb);
    mixer_sub<2>(lds, l, rep, lam, lam_init);
}

typedef float f32x4g __attribute__((ext_vector_type(4)));
__device__ __forceinline__ void inproj_phase(ldsp lds, int l, int G) {
    const kargp_t ap = KARGS(); unsigned char* ws = ap->ws;
    {
        pg8::Gemm g{(const pg8::bf16_t*)(ws + WS_HL), (const pg8::bf16_t*)(ws + WS_WIN) + (size_t)l * NIN * 1024, MTOT, 4096, DM};
        pg8::StaticOrder S; S.init(MTOT, 4096, G, (int)blockIdx.x);
        pg8::EpiIn E{(pg8::bf16_t*)(ws + WS_P), (float*)(ws + WS_GATES), (const float*)(ws + WS_BIAS) + l * NIN, (const float*)(ws + WS_ROPE)};
        pg8::gemm_phase<pg8::EpiIn, pg8::StaticOrder, true, true>(lds, g, S, E);
    }
    {
        const int tid = fresh_tid(), lane = tid & 63, w = tid >> 6, fr = lane & 15, fq = lane >> 4;
        const bf16_t* HL = (const bf16_t*)(ws + WS_HL); const bf16_t* WG = (const bf16_t*)(ws + WS_WIN) + ((size_t)l * NIN + 4096) * 1024;
        float* GATES = (float*)(ws + WS_GATES); const float bias = ((const float*)(ws + WS_BIAS))[l * NIN + 4096 + fr];
        for (int task = blockIdx.x * 8 + w; task < MTOT / 16; task += G * 8) {
            const bf16_t* ap_ = HL + (size_t)(task * 16 + fr) * DM + 8 * fq; const bf16_t* bp_ = WG + (size_t)fr * DM + 8 * fq;
            f32x4g acc = {0.f, 0.f, 0.f, 0.f};
#pragma unroll 8
            for (int kk = 0; kk < 32; ++kk) acc = __builtin_amdgcn_mfma_f32_16x16x32_bf16(*(const bf16x8*)(ap_ + kk * 32), *(const bf16x8*)(bp_ + kk * 32), acc, 0, 0, 0);
#pragma unroll
            for (int r = 0; r < 4; ++r) GATES[(size_t)(task * 16 + fq * 4 + r) * 16 + fr] = acc[r] + bias;
        }
    }
}
__device__ __forceinline__ void outproj_phase(ldsp lds, int l, int G) {
    const kargp_t ap = KARGS(); unsigned char* ws = ap->ws;
    const int Mo = (l == DEPTH - 1) ? ML : MTOT;
    pg8::Gemm g{(const pg8::bf16_t*)(ws + WS_HL), (const pg8::bf16_t*)(ws + WS_WOUT) + (size_t)l * 1024 * 1024, Mo, DM, DM};
    pg8::StaticOrder S; S.init(Mo, DM, G, (int)blockIdx.x);
    pg8::EpiOut E{l == 0 ? ap->x : ap->out, l == 0 ? ap->ctx : (const float*)(ws + WS_XC), ap->out, (float*)(ws + WS_XC), (const float*)(ws + WS_MOD) + (size_t)l * 33 * 3072 + 2048,
                  (const float*)(ws + WS_STATS), ap->ln_g + (l > 0 ? l - 1 : 0) * DM, ap->ln_b + (l > 0 ? l - 1 : 0) * DM, l > 0 ? 1 : 0};
    pg8::gemm_phase<pg8::EpiOut, pg8::StaticOrder, true, true>(lds, g, S, E);
}
template <int L> __device__ __forceinline__ void layer_body(ldsp lds, int G, const XcdBarrier& xb) {
    inproj_phase(lds, L, G);
    xcd_barrier(xb);
    mixer_phase(lds, L, xb);
    xcd_barrier(xb);
    outproj_phase(lds, L, G);
    xcd_barrier(xb);
    rowpass(L + 1, G);
    if (L + 1 < DEPTH) xcd_barrier(xb);
}
__global__ void __launch_bounds__(512, 2) fwd_kernel(Args a) {
    extern __shared__ __attribute__((aligned(16))) unsigned char lds_raw[];
    cg::grid_group grid = cg::this_grid();
    ldsp lds = (ldsp)lds_raw;
    const int G = gridDim.x;
    volatile LAS unsigned* xst = (volatile LAS unsigned*)(lds + LDS_SLOT + 32);
    if (threadIdx.x == 0) { xst[0] = 0u; xst[1] = 0u; }
    __syncthreads();
    const XcdBarrier xb = xcd_barrier_post((unsigned*)(a.ws + WS_CTL) + 8192, xst);
    prologue(lds, G);
    grid.sync();
    rowpass(0, G);
    xcd_barrier(xb);
    layer_body<0>(lds, G, xb); layer_body<1>(lds, G, xb); layer_body<2>(lds, G, xb); layer_body<3>(lds, G, xb);
}

extern "C" void kernel_launch(void* const* d_in, const int* in_sizes, int n_in, void* d_out, int out_size, void* d_ws, size_t ws_size, hipStream_t stream) {
    static int grid = 0;
    if (grid == 0) {
        int dev = 0, cus = 0, per_cu = 0;
        if (hipGetDevice(&dev) != hipSuccess || hipDeviceGetAttribute(&cus, hipDeviceAttributeMultiprocessorCount, dev) != hipSuccess) { fprintf(stderr, "device query failed\n"); grid = -1; return; }
        if (hipFuncSetAttribute((const void*)fwd_kernel, hipFuncAttributeMaxDynamicSharedMemorySize, LDS_BYTES) != hipSuccess) { fprintf(stderr, "hipFuncSetAttribute failed\n"); grid = -1; return; }
        if (hipOccupancyMaxActiveBlocksPerMultiprocessor(&per_cu, (const void*)fwd_kernel, 512, LDS_BYTES) != hipSuccess || per_cu < 1) fprintf(stderr, "occupancy query: %d\n", per_cu);
        (void)hipGetLastError();
        if (ws_size < WS_END) { fprintf(stderr, "workspace too small: %zu < %zu\n", ws_size, (size_t)WS_END); grid = -1; return; }
        grid = cus;
    }
    if (grid < 0) return;
    (void)hipMemsetAsync((char*)d_ws + WS_CTL, 0, CTL_BYTES, stream);
    Args a{};
    const float** ap = (const float**)&a;
    for (int i = 0; i < 23; ++i) ap[i] = (const float*)d_in[i];
    a.out = (float*)d_out; a.ws = (unsigned char*)d_ws;
    void* args[] = {&a};
    hipError_t e = hipLaunchCooperativeKernel((const void*)fwd_kernel, dim3(grid), dim3(512), args, LDS_BYTES, stream);
    if (e != hipSuccess) fprintf(stderr, "cooperative launch failed: %s (grid %d)\n", hipGetErrorString(e), grid);
}
```

```cpp
#include <hip/hip_runtime.h>
#include <hip/hip_cooperative_groups.h>
#include <cstdio>
#include <cstdint>
namespace cg = cooperative_groups;

constexpr int DM = 1024, NBATCH = 32, SEQ = 2048, CTXL = 256, DEPTH = 4;
constexpr int ML = NBATCH * SEQ, MCX = NBATCH * CTXL, MTOT = ML + MCX;
constexpr int NIN = 4352, NINR = 4112;
constexpr int C_MLQ = 0, C_MLK = 256, C_MLV = 512, C_MLO = 768, C_MLZ = 1024, C_DAQ = 1280, C_DAK = 1792, C_DAV = 2304, C_DAZ = 2816,
              C_SGU = 3328, C_SGV = 3584, C_SGZ = 3840, C_GATE = 4096;
constexpr float LN_EPS = 1e-5f;
constexpr float DN_ALPHA = 1.681792830507429f;
constexpr float QSCALE = 0.125f * 1.4426950408889634f;

template <int O> __device__ __forceinline__ float xshf(float v) {
    if constexpr (O < 32) { return __int_as_float(__builtin_amdgcn_ds_swizzle(__float_as_int(v), (O << 10) | 0x1f)); }
    else { const auto r = __builtin_amdgcn_permlane32_swap(__float_as_uint(v), __float_as_uint(v), false, false);
           return __uint_as_float((threadIdx.x & 32) ? r[0] : r[1]); }
}
__device__ __forceinline__ float lshf(float v, int src_lane) { return __int_as_float(__builtin_amdgcn_ds_bpermute(src_lane << 2, __float_as_int(v))); }
namespace pg8 {
#define PG8_LAS __attribute__((address_space(3)))
typedef unsigned short bf16_t;
typedef short bf16x8 __attribute__((ext_vector_type(8)));
typedef float f32x4 __attribute__((ext_vector_type(4)));
typedef unsigned u32x4 __attribute__((ext_vector_type(4)));
constexpr int BM = 256, BK = 64, HALF = 128, HTB = HALF * BK * 2  , STAGE_BYTES = 8 * HTB, NXCD = 8, WGM = 8;

__host__ __device__ __forceinline__ int lds_byte(int r, int c) { const int st = (r >> 4) * 2 + (c >> 5), rr = r & 15, cc = c & 31, ob = rr * 64 + cc * 2; return st * 1024 + (ob ^ (((ob >> 9) & 1) << 5)); }
__host__ __device__ __forceinline__ void stage_rc(int b, int& R, int& C) { const int st = b / 1024, sb = b % 1024, swz = sb ^ (((sb >> 9) & 1) << 5); R = (st >> 1) * 16 + swz / 64; C = (st & 1) * 32 + (swz % 64) / 2; }
__host__ __device__ __forceinline__ int perm32(int rho) { const int n = rho >> 4, i = rho & 15; return 8 * (i >> 2) + 4 * n + (i & 3); }

struct Unit { int pm, pn; };
struct Gemm { const bf16_t* A; const bf16_t* Bt; int M, N, K; };

struct StaticOrder {
    int nM, nN, nwg, G, c;
    __host__ __device__ void init(int M, int N, int G_, int c_) { nM = M / BM; nN = N / BM; nwg = nM * nN; G = G_; c = c_; }
    __host__ __device__ bool next(int i, Unit& u) const {
        const long L = (long)i * G + c; if (L >= nwg) return false;
        int wgid = (int)L; { const int q = nwg / NXCD, r = nwg % NXCD, xcd = wgid % NXCD, off = wgid / NXCD; wgid = (xcd < r ? xcd * (q + 1) : r * (q + 1) + (xcd - r) * q) + off; }
        const int nig = WGM * nN, gid = wgid / nig, fm = gid * WGM, gsz = (nM - fm) < WGM ? (nM - fm) : WGM;
        u.pm = fm + ((wgid % nig) % gsz); u.pn = (wgid % nig) / gsz; return true;
    }
    __device__ __forceinline__ void a_ready(const Unit&) const {}
    __device__ __forceinline__ void done(const Unit&) const {}
};
__device__ __forceinline__ unsigned cvt_pk_bf16(float lo, float hi) { unsigned r; asm volatile("v_cvt_pk_bf16_f32 %0, %1, %2" : "=v"(r) : "v"(lo), "v"(hi)); return r; }
typedef float f32x2 __attribute__((ext_vector_type(2)));
typedef float f32x2 __attribute__((ext_vector_type(2)));
struct EpiIn {
    static constexpr bool PERM = true, AFTER_DRAIN = false;
    bf16_t* P; float* GATES; const float* bias; const float* rope;
    __device__ __forceinline__ void operator()(const f32x4 (&acc)[2][2][4][2], const Unit& u, int wr, int wc, int fr, int fq) const {
        const int row0 = u.pm * BM + wr * 64 + fr, colt = u.pn * BM, col0 = colt + wc * 32 + 8 * fq;
        const bool is_lat = u.pm < (ML / BM);
        const int mode = (u.pn == 5 || u.pn == 6) ? 1 : ((u.pn == 7 || u.pn == 8) ? 2 : (u.pn == 16 ? 3 : 0));
        const bool do_rope = (mode == 1 || mode == 2) && is_lat;
        const float sgn = (fq < 2) ? -1.f : 1.f;
        f32x4 bv[2][2];
#pragma unroll
        for (int bj = 0; bj < 2; ++bj)
#pragma unroll
            for (int n = 0; n < 2; ++n) bv[bj][n] = *(const f32x4*)(bias + col0 + bj * HALF + 4 * n);
#pragma unroll
        for (int ai = 0; ai < 2; ++ai)
#pragma unroll
            for (int m = 0; m < 4; ++m) {
                const int row = row0 + ai * HALF + m * 16;
                const int t = row & (SEQ - 1);
                const int pidx = (wc & 1) ? 32 + (t & 63) : (t >> 6);
                const float* tab = rope + (pidx * 16 + 8 * (fq & 1)) * 2;
#pragma unroll
                for (int bj = 0; bj < 2; ++bj) {
                    f32x4 v0 = acc[ai][bj][m][0] + bv[bj][0], v1 = acc[ai][bj][m][1] + bv[bj][1];
                    if (mode == 1 || mode == 2) {
                        f32x4 p0, p1;
#pragma unroll
                        for (int e = 0; e < 4; ++e) { p0[e] = xshf<32>(v0[e]); p1[e] = xshf<32>(v1[e]); }
                        if (do_rope) {
                            const f32x4 t0 = *(const f32x4*)(tab), t1 = *(const f32x4*)(tab + 4), t2 = *(const f32x4*)(tab + 8), t3 = *(const f32x4*)(tab + 12);
                            v0[0] = v0[0] * t0[0] + sgn * p0[0] * t0[1]; v0[1] = v0[1] * t0[2] + sgn * p0[1] * t0[3];
                            v0[2] = v0[2] * t1[0] + sgn * p0[2] * t1[1]; v0[3] = v0[3] * t1[2] + sgn * p0[3] * t1[3];
                            v1[0] = v1[0] * t2[0] + sgn * p1[0] * t2[1]; v1[1] = v1[1] * t2[2] + sgn * p1[1] * t2[3];
                            v1[2] = v1[2] * t3[0] + sgn * p1[2] * t3[1]; v1[3] = v1[3] * t3[2] + sgn * p1[3] * t3[3];
                        }
                        if (mode == 1) { v0 = v0 * QSCALE; v1 = v1 * QSCALE; }
                    }
                    if (mode == 3) {
                        if (wc == 0 && bj == 0 && fq < 2) { float* gp = GATES + (size_t)row * 16 + 8 * fq; *(f32x4*)gp = v0; *(f32x4*)(gp + 4) = v1; }
                    } else {
                        u32x4 w; w.x = cvt_pk_bf16(v0[0], v0[1]); w.y = cvt_pk_bf16(v0[2], v0[3]); w.z = cvt_pk_bf16(v1[0], v1[1]); w.w = cvt_pk_bf16(v1[2], v1[3]);
                        *(u32x4*)(P + (size_t)row * NIN + col0 + bj * HALF) = w;
                    }
                }
            }
    }
};
struct EpiOut {
    static constexpr bool PERM = false, AFTER_DRAIN = false;
    const float* src_lat; const float* src_ctx; float* dst_lat; float* dst_ctx; const float* gate;
    const float* stats; const float* lng; const float* lnb; int use_ln;
    __device__ __forceinline__ void operator()(const f32x4 (&acc)[2][2][4][2], const Unit& u, int wr, int wc, int fr, int fq) const {
        const int rowt = u.pm * BM; const bool is_lat = u.pm < (ML / BM);
        const int bidx = is_lat ? (rowt >> 11) : 32;
        const float* src = is_lat ? src_lat + (size_t)rowt * DM : src_ctx + (size_t)(rowt - ML) * DM;
        float* dst = is_lat ? dst_lat + (size_t)rowt * DM : dst_ctx + (size_t)(rowt - ML) * DM;
        const int col0 = u.pn * BM + wc * 32 + 4 * fq;
        const float* g = gate + (size_t)bidx * 3072;
        f32x4 gv[2][2], lg[2][2], lb[2][2];
#pragma unroll
        for (int bj = 0; bj < 2; ++bj)
#pragma unroll
            for (int n = 0; n < 2; ++n) { gv[bj][n] = *(const f32x4*)(g + col0 + bj * HALF + n * 16);
                if (use_ln) { lg[bj][n] = *(const f32x4*)(lng + col0 + bj * HALF + n * 16); lb[bj][n] = *(const f32x4*)(lnb + col0 + bj * HALF + n * 16); }
                else { lg[bj][n] = (f32x4){1.f, 1.f, 1.f, 1.f}; lb[bj][n] = (f32x4){0.f, 0.f, 0.f, 0.f}; } }
#pragma unroll
        for (int ai = 0; ai < 2; ++ai)
#pragma unroll
            for (int m = 0; m < 4; ++m) {
                const int r = ai * HALF + wr * 64 + m * 16 + fr;
                const size_t off = (size_t)r * DM + col0;
                float mean = 0.f, rstd = 1.f;
                if (use_ln) { const f32x2 st = *(const f32x2*)(stats + (size_t)(rowt + r) * 2); mean = st.x; rstd = st.y; }
#pragma unroll
                for (int bj = 0; bj < 2; ++bj)
#pragma unroll
                    for (int n = 0; n < 2; ++n) {
                        const f32x4 rv = *(const f32x4*)(src + off + bj * HALF + n * 16);
                        const f32x4 xv = (rv - mean) * rstd * lg[bj][n] + lb[bj][n];
                        *(f32x4*)(dst + off + bj * HALF + n * 16) = xv * DN_ALPHA + gv[bj][n] * acc[ai][bj][m][n];
                    }
            }
    }
};
template <class Epi, class Sched, bool ALIGN_EPI = false, bool SP2 = false>
__device__ __forceinline__ void gemm_phase(PG8_LAS unsigned char* lds, const Gemm g, const Sched& S, const Epi& E) {
    int tid_l = threadIdx.x; asm volatile("" : "+v"(tid_l));
    const int tid = tid_l, wid = __builtin_amdgcn_readfirstlane(tid >> 6), lane = tid & 63, wr = wid >> 2, wc = wid & 3, fr = lane & 15, fq = lane >> 4;
    const int K = g.K, nt = K / BK;
    unsigned voffA[2], voffB[2];
#pragma unroll
    for (int i = 0; i < 2; ++i) { int R, C; stage_rc(tid * 16 + i * 8192, R, C); const int Rb = Epi::PERM ? ((R & ~31) + perm32(R & 31)) : R;
        voffA[i] = (unsigned)(R * K + C) * 2u; voffB[i] = (unsigned)(Rb * K + C) * 2u; }
    const size_t kstep = (size_t)(BK * 2);
    const size_t hstep = (size_t)HALF * K * 2;
    const size_t tstep = 2 * hstep;
    const unsigned ldsw = (unsigned)wid * 1024u;
    const int aoff = lds_byte(wr * 64 + fr, fq * 8), boff = lds_byte(wc * 32 + fr, fq * 8);
#define PG8_SA(b, h) (((b) * 2 + (h)) * HTB)
#define PG8_SB(b, h) ((4 + (b) * 2 + (h)) * HTB)
#define PG8_STAGE(bufoff, gbase, voff) do { _Pragma("unroll") for (int _i = 0; _i < 2; ++_i) \
        __builtin_amdgcn_global_load_lds((const unsigned*)((const char*)(gbase) + (voff)[_i]), (PG8_LAS unsigned*)(lds + (bufoff) + ldsw + _i * 8192), 16, 0, 0); } while (0)
#define PG8_LDA(dst, b, h) do { _Pragma("unroll") for (int m = 0; m < 4; ++m) _Pragma("unroll") for (int k = 0; k < 2; ++k) dst[m][k] = *(const PG8_LAS bf16x8*)(lds + PG8_SA(b, h) + aoff + m * 2048 + k * 1024); } while (0)
#define PG8_LDB(dst, b, h) do { _Pragma("unroll") for (int n = 0; n < 2; ++n) _Pragma("unroll") for (int k = 0; k < 2; ++k) dst[n][k] = *(const PG8_LAS bf16x8*)(lds + PG8_SB(b, h) + boff + n * 2048 + k * 1024); } while (0)
#define PG8_MMA(ai, bj, At, Bt) do { __builtin_amdgcn_s_setprio(1); _Pragma("unroll") for (int m = 0; m < 4; ++m) _Pragma("unroll") for (int n = 0; n < 2; ++n) _Pragma("unroll") for (int k = 0; k < 2; ++k) \
        acc[ai][bj][m][n] = __builtin_amdgcn_mfma_f32_16x16x32_bf16(Bt[n][k], At[m][k], acc[ai][bj][m][n], 0, 0, 0); __builtin_amdgcn_s_setprio(0); } while (0)
#define PG8_WAIT_V(n) asm volatile("s_waitcnt vmcnt(" #n ")" ::: "memory")
#define PG8_WAIT_L(n) asm volatile("s_waitcnt lgkmcnt(" #n ")" ::: "memory")
#define PG8_BAR __builtin_amdgcn_s_barrier()
#define PG8_SCHED __builtin_amdgcn_sched_barrier(0)
    Unit cur, nxt; int ui = 0;
    if (!S.next(0, cur)) return;
    f32x4 acc[2][2][4][2];
#pragma unroll
    for (int a = 0; a < 2; ++a)
#pragma unroll
        for (int b = 0; b < 2; ++b)
#pragma unroll
            for (int m = 0; m < 4; ++m)
#pragma unroll
                for (int n = 0; n < 2; ++n) acc[a][b][m][n] = (f32x4){0.f, 0.f, 0.f, 0.f};
    bf16x8 At[4][2], B0[2][2], B1[2][2];
    const char* cA = (const char*)g.A + (size_t)cur.pm * tstep; const char* cB = (const char*)g.Bt + (size_t)cur.pn * tstep;
    S.a_ready(cur);
    if constexpr (SP2) {
        PG8_STAGE(PG8_SB(0, 0), cB, voffB); PG8_STAGE(PG8_SB(0, 1), cB + hstep, voffB); PG8_STAGE(PG8_SA(0, 0), cA, voffA); PG8_STAGE(PG8_SA(0, 1), cA + hstep, voffA);
        if (wr == 1) PG8_BAR;
        PG8_WAIT_V(2); PG8_BAR;
        PG8_STAGE(PG8_SB(1, 0), cB + kstep, voffB); PG8_STAGE(PG8_SA(1, 0), cA + kstep, voffA); PG8_STAGE(PG8_SB(1, 1), cB + hstep + kstep, voffB);
        PG8_WAIT_V(6); PG8_BAR;
    } else {
        PG8_STAGE(PG8_SB(0, 0), cB, voffB); PG8_STAGE(PG8_SA(0, 0), cA, voffA); PG8_STAGE(PG8_SB(0, 1), cB + hstep, voffB); PG8_STAGE(PG8_SA(0, 1), cA + hstep, voffA);
        if (wr == 1) PG8_BAR;
        PG8_WAIT_V(4); PG8_BAR;
        PG8_STAGE(PG8_SB(1, 0), cB + kstep, voffB); PG8_STAGE(PG8_SA(1, 0), cA + kstep, voffA); PG8_STAGE(PG8_SB(1, 1), cB + hstep + kstep, voffB);
        PG8_WAIT_V(6); PG8_BAR;
    }
    for (;;) {
        const bool has_next = S.next(ui + 1, nxt);
        const char* nA = has_next ? (const char*)g.A + (size_t)nxt.pm * tstep : cA; const char* nB = has_next ? (const char*)g.Bt + (size_t)nxt.pn * tstep : cB;
        for (int t = 0; t < nt; t += 2) {
            const bool last = (t == nt - 2);
            const char* a1 = cA + (size_t)(t + 1) * kstep;
            const char* a2 = last ? nA : cA + (size_t)(t + 2) * kstep; const char* b2 = last ? nB : cB + (size_t)(t + 2) * kstep;
            const char* a3 = a2 + kstep; const char* b3 = b2 + kstep;
            if (last && has_next) S.a_ready(nxt);
            if constexpr (SP2) {
            PG8_LDB(B0, 0, 0); PG8_LDB(B1, 0, 1); PG8_SCHED; PG8_LDA(At, 0, 0); PG8_STAGE(PG8_SA(1, 1), a1 + hstep, voffA);
            PG8_WAIT_V(8); PG8_WAIT_L(0); PG8_BAR; PG8_MMA(0, 0, At, B0); PG8_MMA(0, 1, At, B1); PG8_BAR; PG8_SCHED;
            PG8_LDA(At, 0, 1); PG8_STAGE(PG8_SB(0, 0), b2, voffB); PG8_STAGE(PG8_SB(0, 1), b2 + hstep, voffB); PG8_STAGE(PG8_SA(0, 0), a2, voffA);
            PG8_WAIT_V(8); PG8_WAIT_L(0); PG8_BAR; PG8_MMA(1, 0, At, B0); PG8_MMA(1, 1, At, B1); PG8_BAR; PG8_SCHED;
            PG8_LDB(B0, 1, 0); PG8_LDB(B1, 1, 1); PG8_SCHED; PG8_LDA(At, 1, 0); PG8_STAGE(PG8_SA(0, 1), a2 + hstep, voffA);
            PG8_WAIT_V(8); PG8_WAIT_L(0); PG8_BAR; PG8_MMA(0, 0, At, B0); PG8_MMA(0, 1, At, B1); PG8_BAR; PG8_SCHED;
            PG8_LDA(At, 1, 1); PG8_STAGE(PG8_SB(1, 0), b3, voffB); PG8_STAGE(PG8_SB(1, 1), b3 + hstep, voffB); PG8_STAGE(PG8_SA(1, 0), a3, voffA);
            PG8_WAIT_V(8); PG8_WAIT_L(0); PG8_BAR; PG8_MMA(1, 0, At, B0); PG8_MMA(1, 1, At, B1); PG8_BAR; PG8_SCHED;
            } else {
            PG8_LDB(B0, 0, 0); PG8_SCHED; PG8_LDA(At, 0, 0); PG8_STAGE(PG8_SA(1, 1), a1 + hstep, voffA);
            PG8_WAIT_L(8); PG8_BAR; PG8_WAIT_L(0); PG8_MMA(0, 0, At, B0); PG8_BAR; PG8_SCHED;
            PG8_LDB(B1, 0, 1); PG8_STAGE(PG8_SB(0, 0), b2, voffB);
            PG8_BAR; PG8_WAIT_L(0); PG8_MMA(0, 1, At, B1); PG8_BAR;
            PG8_LDA(At, 0, 1); PG8_STAGE(PG8_SA(0, 0), a2, voffA);
            PG8_BAR; PG8_WAIT_L(0); PG8_MMA(1, 0, At, B0); PG8_BAR; PG8_SCHED;
            PG8_STAGE(PG8_SB(0, 1), b2 + hstep, voffB);
            PG8_WAIT_V(6); PG8_BAR; PG8_MMA(1, 1, At, B1); PG8_BAR;
            PG8_LDB(B0, 1, 0); PG8_SCHED; PG8_LDA(At, 1, 0); PG8_STAGE(PG8_SA(0, 1), a2 + hstep, voffA);
            PG8_WAIT_L(8); PG8_BAR; PG8_WAIT_L(0); PG8_MMA(0, 0, At, B0); PG8_BAR; PG8_SCHED;
            PG8_LDB(B1, 1, 1); PG8_STAGE(PG8_SB(1, 0), b3, voffB);
            PG8_BAR; PG8_WAIT_L(0); PG8_MMA(0, 1, At, B1); PG8_BAR;
            PG8_LDA(At, 1, 1); PG8_STAGE(PG8_SA(1, 0), a3, voffA);
            PG8_BAR; PG8_WAIT_L(0); PG8_MMA(1, 0, At, B0); PG8_BAR; PG8_SCHED;
            PG8_STAGE(PG8_SB(1, 1), b3 + hstep, voffB);
            PG8_WAIT_V(6); PG8_BAR; PG8_MMA(1, 1, At, B1); PG8_BAR;
            }
        }
        if constexpr (ALIGN_EPI) { if (wr == 0) PG8_BAR; }
        if constexpr (!Epi::AFTER_DRAIN) { E(acc, cur, wr, wc, fr, fq); S.done(cur); }
        if (!has_next) break;
#pragma unroll
        for (int a = 0; a < 2; ++a)
#pragma unroll
            for (int b = 0; b < 2; ++b)
#pragma unroll
                for (int m = 0; m < 4; ++m)
#pragma unroll
                    for (int n = 0; n < 2; ++n) acc[a][b][m][n] = (f32x4){0.f, 0.f, 0.f, 0.f};
        cur = nxt; cA = nA; cB = nB; ++ui;
        if constexpr (ALIGN_EPI) { if (wr == 1) PG8_BAR; }
    }
    PG8_WAIT_V(0);
    if constexpr (!ALIGN_EPI) { if (wr == 0) PG8_BAR; }
    PG8_BAR;
    if constexpr (Epi::AFTER_DRAIN) { E.fused(acc, cur, wr, wc, fr, fq, lds, wid, lane); S.done(cur); }
#undef PG8_SA
#undef PG8_SB
#undef PG8_STAGE
#undef PG8_LDA
#undef PG8_LDB
#undef PG8_MMA
#undef PG8_WAIT_V
#undef PG8_WAIT_L
#undef PG8_BAR
#undef PG8_SCHED
}
}

#define LAS __attribute__((address_space(3)))
typedef unsigned short bf16_t;
typedef short bf16x8 __attribute__((ext_vector_type(8)));
typedef short s16x4 __attribute__((ext_vector_type(4)));
typedef float f32x4 __attribute__((ext_vector_type(4)));
typedef float f32x16 __attribute__((ext_vector_type(16)));
typedef unsigned u32x4 __attribute__((ext_vector_type(4)));
typedef unsigned u32x2 __attribute__((ext_vector_type(2)));
typedef LAS unsigned char* ldsp;

__device__ __forceinline__ float bf2f(short b) { return __uint_as_float(((unsigned)(unsigned short)b) << 16); }
__device__ __forceinline__ unsigned short f2bf(float f) { const unsigned u = __float_as_uint(f); return (unsigned short)((u + 0x7fffu + ((u >> 16) & 1u)) >> 16); }
typedef float f32x2_t __attribute__((ext_vector_type(2))); typedef __bf16 bf16x2_t __attribute__((ext_vector_type(2)));
__device__ __forceinline__ unsigned pk2(float lo, float hi) { f32x2_t v = {lo, hi}; bf16x2_t b = __builtin_convertvector(v, bf16x2_t); return __builtin_bit_cast(unsigned, b); }
__device__ __forceinline__ float silu_f(float x) { return x / (1.f + __expf(-x)); }
__device__ __forceinline__ float sigmoid_f(float x) { return 1.f / (1.f + __expf(-x)); }
__device__ __forceinline__ float gelu_f(float x) { return 0.5f * x * (1.f + erff(x * 0.70710678118654752f)); }
__device__ __forceinline__ float gelu_fast(float v) {
    const float av = fabsf(v), d = av * 0.2316418882f + 1.0f, t = __builtin_amdgcn_rcpf(d);
    float q = t * 0.5307027145f + (-0.7265760135f); q = q * t + 0.7107068705f; q = q * t + (-0.142248368f); q = q * t + 0.127414796f; q = q * t;
    const float e = __builtin_amdgcn_exp2f((v * v) * (-0.72134752044f));
    const float m = v * (q * e), r = v - m; return v < 0.f ? m : r;
}
__device__ __forceinline__ float logsigmoid_f(float x) { return fminf(x, 0.f) - log1pf(expf(-fabsf(x))); }
__device__ __forceinline__ float wave_sum(float v) {
    v += xshf<1>(v); v += xshf<2>(v); v += xshf<4>(v); v += xshf<8>(v); v += xshf<16>(v); v += xshf<32>(v);
    return v;
}
__device__ __forceinline__ bf16x8 pack8(const float* v) {
    u32x4 w; w.x = pk2(v[0], v[1]); w.y = pk2(v[2], v[3]); w.z = pk2(v[4], v[5]); w.w = pk2(v[6], v[7]);
    return __builtin_bit_cast(bf16x8, w);
}
#define MFMA32(a, b, c) __builtin_amdgcn_mfma_f32_32x32x16_bf16((a), (b), (c), 0, 0, 0)
__device__ __forceinline__ int crow(int r, int hh) { return (r & 3) + 8 * (r >> 2) + 4 * hh; }

constexpr size_t MiB = 1u << 20;
constexpr size_t WS_CTL = 0, CTL_BYTES = 65536;
constexpr size_t WS_MOD = 1 * MiB;
constexpr size_t WS_BIAS = 3 * MiB;
constexpr size_t WS_ROPE = 3 * MiB + 512 * 1024;
constexpr size_t WS_WOUT = 4 * MiB;
constexpr size_t WS_WIN = 12 * MiB;
constexpr size_t WS_XC = 46 * MiB;
constexpr size_t WS_HL = 78 * MiB;
constexpr size_t WS_CLOC = 222 * MiB;
constexpr size_t WS_P = 294 * MiB;
constexpr size_t WS_GATES = 906 * MiB;
constexpr size_t WS_WSB2 = 912 * MiB;
constexpr size_t WS_QK = 914 * MiB;
constexpr size_t WS_CPREV = 986 * MiB;
constexpr size_t WS_NLOC = 910 * MiB + 512 * 1024;
constexpr size_t WS_NPREV = 912 * MiB + 512 * 1024;
constexpr size_t WS_SCL = 913 * MiB + 768 * 1024;
constexpr size_t WS_GARR = 3 * MiB + 640 * 1024;
constexpr size_t WS_STATS = 1022 * MiB;
constexpr size_t WS_END = 1023 * MiB;

constexpr int LDS_BYTES = 147456;
constexpr int LDS_SLOT = LDS_BYTES - 64;

struct Args {
    const float *x, *c, *ctx, *c_ctx, *w_mod, *b_mod, *w_in, *b_in, *conv_w, *conv_b, *ml_g, *lq1, *lk1, *lq2, *lk2, *da_g, *sg_g, *sg_b, *w_s, *b_s, *w_out, *ln_g, *ln_b;
    float* out; unsigned char* ws;
};


typedef const __attribute__((address_space(4))) struct Args* kargp_t;
#define KARGS() ({ kargp_t p_ = (kargp_t)__builtin_amdgcn_kernarg_segment_ptr(); asm volatile("" : "+s"(p_)); p_; })
__device__ __forceinline__ int fresh_tid() { int t = threadIdx.x; asm volatile("" : "+v"(t)); return t; }

__device__ __forceinline__ int win_orig_col(int n) { return n < 1280 ? n : (n < 4096 ? n + 16 : (n < 4112 ? n - 4096 + 1280 : -1)); }

__device__ __forceinline__ void transpose_item(const float* W, int ldw, bf16_t* WT, int k0, int n0, bool is_win, LAS float* scr, int lane) {
    const int np = n0 + (lane & 31); const int oc = is_win ? win_orig_col(np) : np;
#pragma unroll 8
    for (int i = 0; i < 32; ++i) { const int kk = 2 * i + (lane >> 5); scr[kk * 33 + (lane & 31)] = (oc >= 0) ? W[(size_t)(k0 + kk) * ldw + oc] : 0.f; }
    asm volatile("s_waitcnt lgkmcnt(0)" ::: "memory");
    const int c = lane & 7;
#pragma unroll
    for (int j = 0; j < 4; ++j) { const int n = (lane >> 3) + 8 * j; const LAS float* s = scr + (8 * c) * 33 + n;
        u32x4 o; o.x = pk2(s[0 * 33], s[1 * 33]); o.y = pk2(s[2 * 33], s[3 * 33]); o.z = pk2(s[4 * 33], s[5 * 33]); o.w = pk2(s[6 * 33], s[7 * 33]);
        *(u32x4*)(WT + (size_t)(n0 + n) * 1024 + k0 + 8 * c) = o; }
    asm volatile("s_waitcnt lgkmcnt(0)" ::: "memory");
}

__device__ __forceinline__ void prologue(ldsp lds, int G) {
    const kargp_t ap = KARGS();
    const int tid = fresh_tid(), lane = tid & 63, w = tid >> 6;
    const int gw = blockIdx.x * 8 + w, NGW = G * 8;
    bf16_t* WIN = (bf16_t*)(ap->ws + WS_WIN); bf16_t* WOUT = (bf16_t*)(ap->ws + WS_WOUT);
    LAS float* scr = (LAS float*)(lds + w * 8448);
    for (int it = gw; it < 8704 + 2048; it += NGW) {
        if (it < 8704) { const int l = it / 2176, r = it % 2176, kb = r / 136, nb = r % 136;
            transpose_item(ap->w_in + (size_t)l * 1024 * NINR, NINR, WIN + (size_t)l * NIN * 1024, kb * 64, nb * 32, true, scr, lane); }
        else { const int r2 = it - 8704, l = r2 / 512, r = r2 % 512, kb = r / 32, nb = r % 32;
            transpose_item(ap->w_out + (size_t)l * 1024 * 1024, 1024, WOUT + (size_t)l * 1024 * 1024, kb * 64, nb * 32, false, scr, lane); }
    }
    const int gt = blockIdx.x * 512 + tid, NGT = G * 512;
    float* BIAS = (float*)(ap->ws + WS_BIAS); float* ROPE = (float*)(ap->ws + WS_ROPE); bf16_t* WSB = (bf16_t*)(ap->ws + WS_WSB2);
    for (int i = gt; i < DEPTH * NIN; i += NGT) { const int l = i / NIN, n = i % NIN, oc = win_orig_col(n); BIAS[i] = oc >= 0 ? ap->b_in[l * NINR + oc] : 0.f; }
    for (int i = gt; i < DEPTH * 4 * 128 * 128; i += NGT) WSB[i] = f2bf(ap->w_s[i]);
    for (int i = gt; i < 96 * 16; i += NGT) { const int p = i >> 4, f = i & 15; const float pos = (float)(p < 32 ? p : p - 32);
        const float inv = powf(10000.f, -(float)f / 16.f); const float ang = pos * inv; ROPE[2 * i] = cosf(ang); ROPE[2 * i + 1] = sinf(ang); }
    __syncthreads();
    float* MOD = (float*)(ap->ws + WS_MOD);
    LAS float* SC = (LAS float*)lds;
    LAS float* RED = (LAS float*)(lds + 33 * 1024 * 4);
    bool table = false;
    for (int item = blockIdx.x; item < DEPTH * 48; item += G) {
        if (!table) { for (int i = tid; i < 33 * 1024; i += 512) { const float v = (i < 32 * 1024) ? ap->c[i] : ap->c_ctx[i - 32 * 1024]; SC[i] = silu_f(v); } table = true; }
        __syncthreads();
        const int l = item / 48, j0 = (item % 48) * 64;
        const float* wm = ap->w_mod + (size_t)l * 1024 * 3072 + j0 + lane;
        float acc[33];
#pragma unroll
        for (int r = 0; r < 33; ++r) acc[r] = 0.f;
#pragma unroll 4
        for (int k = w * 128; k < w * 128 + 128; k += 4) {
            const float w0 = wm[(size_t)k * 3072], w1 = wm[(size_t)(k + 1) * 3072], w2 = wm[(size_t)(k + 2) * 3072], w3 = wm[(size_t)(k + 3) * 3072];
#pragma unroll
            for (int r = 0; r < 33; ++r) { const f32x4 s = *(const LAS f32x4*)(SC + r * 1024 + k); acc[r] += (s[0] * w0 + s[1] * w1) + (s[2] * w2 + s[3] * w3); }
        }
        for (int ww = 0; ww < 8; ++ww) {
            if (w == ww) {
#pragma unroll
                for (int r = 0; r < 33; ++r) { if (ww == 0) RED[r * 64 + lane] = acc[r]; else RED[r * 64 + lane] += acc[r]; }
            }
            __syncthreads();
        }
        for (int i = tid; i < 33 * 64; i += 512) { const int r = i >> 6, j = i & 63; MOD[((size_t)l * 33 + r) * 3072 + j0 + j] = RED[i] + ap->b_mod[l * 3072 + j0 + j]; }
        __syncthreads();
    }
}

__device__ __forceinline__ void rowpass(int l, int G) {
    const kargp_t ap = KARGS();
    const int tid = fresh_tid(), lane = tid & 63, w = tid >> 6;
    const int gw = blockIdx.x * 8 + w, NGW = G * 8;
    const int nrows = (l == DEPTH) ? ML : MTOT;
    float* XC = (float*)(ap->ws + WS_XC); bf16_t* HL = (bf16_t*)(ap->ws + WS_HL); const float* MOD = (const float*)(ap->ws + WS_MOD);
#pragma unroll 4
    for (int m = gw; m < nrows; m += NGW) {
        const bool lat = m < ML;
        const float* src = (l == 0) ? (lat ? ap->x + (size_t)m * DM : ap->ctx + (size_t)(m - ML) * DM) : (lat ? ap->out + (size_t)m * DM : XC + (size_t)(m - ML) * DM);
        f32x4 v[4];
#pragma unroll
        for (int j = 0; j < 4; ++j) v[j] = *(const f32x4*)(src + 4 * lane + 256 * j);
        if (l > 0) {
            float s = 0.f;
#pragma unroll
            for (int j = 0; j < 4; ++j) s += (v[j][0] + v[j][1]) + (v[j][2] + v[j][3]);
            const float mean = wave_sum(s) * (1.f / DM); float s2 = 0.f;
#pragma unroll
            for (int j = 0; j < 4; ++j) { v[j] = v[j] - mean; s2 += (v[j][0] * v[j][0] + v[j][1] * v[j][1]) + (v[j][2] * v[j][2] + v[j][3] * v[j][3]); }
            const float rstd = 1.f / sqrtf(wave_sum(s2) * (1.f / DM) + LN_EPS);
            float* dst = lat ? ap->out + (size_t)m * DM : XC + (size_t)(m - ML) * DM;
            if (l < DEPTH && lane == 0) { float* st = (float*)(ap->ws + WS_STATS) + (size_t)m * 2; st[0] = mean; st[1] = rstd; }
#pragma unroll
            for (int j = 0; j < 4; ++j) { const f32x4 g = *(const f32x4*)(ap->ln_g + (l - 1) * DM + 4 * lane + 256 * j), bb = *(const f32x4*)(ap->ln_b + (l - 1) * DM + 4 * lane + 256 * j);
                v[j] = v[j] * rstd * g + bb; if (l == DEPTH) *(f32x4*)(dst + 4 * lane + 256 * j) = v[j]; }
        }
        if (l < DEPTH) {
            float s = 0.f;
#pragma unroll
            for (int j = 0; j < 4; ++j) s += (v[j][0] + v[j][1]) + (v[j][2] + v[j][3]);
            const float mean = wave_sum(s) * (1.f / DM); float s2 = 0.f;
#pragma unroll
            for (int j = 0; j < 4; ++j) { v[j] = v[j] - mean; s2 += (v[j][0] * v[j][0] + v[j][1] * v[j][1]) + (v[j][2] * v[j][2] + v[j][3] * v[j][3]); }
            const float rstd = 1.f / sqrtf(wave_sum(s2) * (1.f / DM) + LN_EPS);
            const int bidx = lat ? (m >> 11) : 32;
            const float* md = MOD + ((size_t)l * 33 + bidx) * 3072;
            bf16_t* o = HL + (size_t)m * DM;
#pragma unroll
            for (int j = 0; j < 4; ++j) { const f32x4 sh = *(const f32x4*)(md + 4 * lane + 256 * j), sc = *(const f32x4*)(md + 1024 + 4 * lane + 256 * j);
                const f32x4 h = v[j] * rstd * (sc + 1.f) + sh; u32x2 pk; pk.x = pk2(h[0], h[1]); pk.y = pk2(h[2], h[3]); *(u32x2*)(o + 4 * lane + 256 * j) = pk; }
        }
    }
}

constexpr int AT_KB = 16384, AT_BUF = 32768, AT_OB = 0, AT_OS = 65536;
__device__ __forceinline__ void at_glds16(const void* gsrc, unsigned lds_dst) { unsigned keep;
    asm volatile("s_mov_b32 %0, m0\n\ts_mov_b32 m0, %2\n\ts_nop 0\n\tglobal_load_lds_dwordx4 %1, off\n\ts_mov_b32 m0, %0" : "=&s"(keep) : "v"(gsrc), "s"(lds_dst) : "memory"); }
__device__ __forceinline__ void attn_item(ldsp lds, int l, int b, int h, int qb, bool is_ctx, float lam, float lam_init) {
    const kargp_t ap = KARGS();
    const bf16_t* __restrict__ P = (const bf16_t*)(ap->ws + WS_P); bf16_t* __restrict__ mix = (bf16_t*)(ap->ws + WS_HL); const float* __restrict__ da_g = ap->da_g + l * 128;
    const int tid = fresh_tid(), lane = tid & 63, w = __builtin_amdgcn_readfirstlane(tid >> 6), r32 = lane & 31, hh = lane >> 5;
    const int c = w >> 2, wq = w & 3;
    const int qrow0 = (is_ctx ? ML + b * CTXL : b * SEQ) + qb * 128;
    bf16x8 qf[4];
    { const bf16_t* qp = P + (size_t)(qrow0 + wq * 32 + r32) * NIN + C_DAQ + h * 128 + c * 64 + 8 * hh;
#pragma unroll
      for (int ks = 0; ks < 4; ++ks) qf[ks] = *(const bf16x8*)(qp + 16 * ks); }
    f32x16 o[4];
#pragma unroll
    for (int d = 0; d < 4; ++d)
#pragma unroll
        for (int r = 0; r < 16; ++r) o[d][r] = 0.f;
    float mrun = 0.f, lrun = 0.f;
    f32x16 negm;
#pragma unroll
    for (int r = 0; r < 16; ++r) negm[r] = 0.f;
    const int ntiles = is_ctx ? 4 : 36;
    const int drow = lane >> 4, dpc = lane & 15;
    const unsigned ldsw = (unsigned)w * 2048u;
    const int vq = (lane & 15) >> 2, vlo = ((lane >> 4) & 1) * 2 + ((lane & 3) >> 1), vhalf8 = (lane & 1) * 8, vtr_row = (4 * hh + vq) * 256;
#define AT_TILE_ROW(t) (is_ctx ? (ML + b * CTXL + (t) * 64) : ((t) < 32 ? b * SEQ + (t) * 64 : ML + b * CTXL + ((t) - 32) * 64))
#define AT_DMA(t, bufo) do { const bf16_t* rp_ = P + (size_t)(AT_TILE_ROW(t) + 8 * w + drow) * NIN + h * 128; \
        _Pragma("unroll") for (int j_ = 0; j_ < 2; ++j_) { const int rr_ = 8 * w + 4 * j_ + drow; \
            at_glds16(rp_ + (size_t)(4 * j_) * NIN + C_DAK + ((dpc ^ (rr_ & 15)) << 3), (unsigned)__builtin_amdgcn_readfirstlane((int)(lds0 + (unsigned)(bufo) + ldsw + j_ * 1024))); \
            at_glds16(rp_ + (size_t)(4 * j_) * NIN + C_DAV + ((dpc ^ ((rr_ & 3) << 2)) << 3), (unsigned)__builtin_amdgcn_readfirstlane((int)(lds0 + (unsigned)(bufo) + AT_KB + ldsw + j_ * 1024))); } } while (0)
    const unsigned lds0 = (unsigned)(size_t)lds;
    __syncthreads();
#define AT_BAR() do { __builtin_amdgcn_s_barrier(); asm volatile("" ::: "memory"); } while (0)
    AT_DMA(0, 0); AT_DMA(1, AT_BUF);
    asm volatile("s_waitcnt vmcnt(4)" ::: "memory");
    AT_BAR();
    if (c == 1) AT_BAR();
    int bo = 0, bn = 2 * AT_BUF;
    for (int t = 0; t < ntiles; ++t) {
        f32x16 p0, p1;
#pragma unroll
        for (int ks = 0; ks < 4; ++ks) {
            const bf16x8 k0 = *(const LAS bf16x8*)(lds + bo + r32 * 256 + (((c * 8 + 2 * ks + hh) ^ (r32 & 15)) << 4));
            const bf16x8 k1 = *(const LAS bf16x8*)(lds + bo + (32 + r32) * 256 + (((c * 8 + 2 * ks + hh) ^ (r32 & 15)) << 4));
            if (ks == 0) { p0 = MFMA32(k0, qf[0], negm); p1 = MFMA32(k1, qf[0], negm); }
            else { p0 = MFMA32(k0, qf[ks], p0); p1 = MFMA32(k1, qf[ks], p1); }
        }
        float tm = fmaxf(fmaxf(p0[0], p0[1]), p1[0]);
#pragma unroll
        for (int r = 1; r < 16; ++r) tm = fmaxf(fmaxf(tm, p0[r]), p1[r]);
        tm = fmaxf(tm, xshf<32>(tm));
        if (t == 0) {
            mrun = tm;
#pragma unroll
            for (int r = 0; r < 16; ++r) { p0[r] -= tm; p1[r] -= tm; negm[r] = -mrun; }
        } else if (__any(tm > 8.f)) {
            const float dl = fmaxf(tm, 0.f), alpha = __builtin_amdgcn_exp2f(-dl);
            mrun += dl; lrun *= alpha;
#pragma unroll
            for (int r = 0; r < 16; ++r) { p0[r] -= dl; p1[r] -= dl; negm[r] = -mrun; }
#pragma unroll
            for (int d = 0; d < 4; ++d)
#pragma unroll
                for (int r = 0; r < 16; ++r) o[d][r] *= alpha;
        }
        float ls = 0.f;
#pragma unroll
        for (int r = 0; r < 16; ++r) { p0[r] = __builtin_amdgcn_exp2f(p0[r]); p1[r] = __builtin_amdgcn_exp2f(p1[r]); ls += p0[r] + p1[r]; }
        lrun += ls;
        bf16x8 pw[4];
#pragma unroll
        for (int kb = 0; kb < 2; ++kb)
#pragma unroll
            for (int s = 0; s < 2; ++s) {
                float pv[8];
#pragma unroll
                for (int e = 0; e < 8; ++e) pv[e] = kb ? p1[8 * s + e] : p0[8 * s + e];
                pw[kb * 2 + s] = pack8(pv);
            }
        asm volatile("s_waitcnt vmcnt(0) lgkmcnt(0)" ::: "memory");
        AT_BAR();
        if (t + 2 < ntiles) AT_DMA(t + 2, bn);
#pragma unroll
        for (int kb = 0; kb < 2; ++kb)
#pragma unroll
            for (int s = 0; s < 2; ++s) {
#pragma unroll
                for (int d = 0; d < 4; ++d) {
                    const int off = bo + AT_KB + vtr_row + (kb * 32 + 16 * s) * 256 + (((d ^ vq) * 4 + vlo) << 4) + vhalf8;
                    const s16x4 lo = __builtin_bit_cast(s16x4, __builtin_amdgcn_ds_read_tr16_b64_v4i16((LAS s16x4*)(lds + off)));
                    const s16x4 hi = __builtin_bit_cast(s16x4, __builtin_amdgcn_ds_read_tr16_b64_v4i16((LAS s16x4*)(lds + off + 8 * 256)));
                    const bf16x8 afrag = {lo[0], lo[1], lo[2], lo[3], hi[0], hi[1], hi[2], hi[3]};
                    o[d] = MFMA32(afrag, pw[kb * 2 + s], o[d]);
                }
            }
        asm volatile("s_waitcnt lgkmcnt(0)" ::: "memory");
        AT_BAR();
        bo = (bo == 2 * AT_BUF) ? 0 : bo + AT_BUF; bn = (bn == 2 * AT_BUF) ? 0 : bn + AT_BUF;
    }
    if (c == 0) AT_BAR();
#undef AT_BAR
#undef AT_TILE_ROW
#undef AT_DMA
    { const float lt = lrun + xshf<32>(lrun); const float inv = 1.f / lt;
#pragma unroll
      for (int d = 0; d < 4; ++d)
#pragma unroll
          for (int r = 0; r < 16; ++r) o[d][r] *= inv; }
    __syncthreads();
    if (c == 1) {
#pragma unroll
        for (int d = 0; d < 4; ++d)
#pragma unroll
            for (int r = 0; r < 16; ++r) *(LAS float*)(lds + AT_OB + ((wq * 64 + d * 16 + r) * 64 + lane) * 4) = o[d][r];
    }
    __syncthreads();
    if (c == 0) {
        float ss = 0.f;
#pragma unroll
        for (int d = 0; d < 4; ++d)
#pragma unroll
            for (int r = 0; r < 16; ++r) { const float o1 = *(const LAS float*)(lds + AT_OB + ((wq * 64 + d * 16 + r) * 64 + lane) * 4); const float v = o[d][r] - lam * o1; o[d][r] = v; ss += v * v; }
        ss += xshf<32>(ss);
        const float rs = rsqrtf(ss * (1.f / 128.f) + LN_EPS) * (1.f - lam_init);
#pragma unroll
        for (int d = 0; d < 4; ++d)
#pragma unroll
            for (int r = 0; r < 16; ++r) *(LAS float*)(lds + AT_OS + ((wq * 32 + r32) * 132 + d * 32 + crow(r, hh)) * 4) = o[d][r] * rs;
    }
    __syncthreads();
    if (c == 0) {
#pragma unroll 2
        for (int it = 0; it < 8; ++it) {
            const int id = it * 64 + lane, row = id >> 4, ch = id & 15;
            const f32x4 a0 = *(const LAS f32x4*)(lds + AT_OS + ((wq * 32 + row) * 132 + ch * 8) * 4), a1 = *(const LAS f32x4*)(lds + AT_OS + ((wq * 32 + row) * 132 + ch * 8 + 4) * 4);
            const size_t grow = (size_t)(qrow0 + wq * 32 + row);
            const bf16x8 z = *(const bf16x8*)(P + grow * NIN + C_DAZ + h * 128 + ch * 8);
            const f32x4 g0 = *(const f32x4*)(da_g + ch * 8), g1 = *(const f32x4*)(da_g + ch * 8 + 4);
            float y[8];
#pragma unroll
            for (int e = 0; e < 4; ++e) { y[e] = a0[e] * g0[e] * silu_f(bf2f(z[e])); y[4 + e] = a1[e] * g1[e] * silu_f(bf2f(z[4 + e])); }
            *(bf16x8*)(mix + grow * DM + 256 + h * 128 + ch * 8) = pack8(y);
        }
    }
}

constexpr int SG_V = 0, SG_YS = 73728;
__device__ __forceinline__ void sgu_item(ldsp lds, int l, int row0) {
    const kargp_t ap = KARGS();
    const bf16_t* __restrict__ P = (const bf16_t*)(ap->ws + WS_P); bf16_t* __restrict__ mix = (bf16_t*)(ap->ws + WS_HL);
    const bf16_t* __restrict__ wsb = (const bf16_t*)(ap->ws + WS_WSB2) + (size_t)l * 4 * 128 * 128;
    const float* __restrict__ sg_g = ap->sg_g + l * 256; const float* __restrict__ sg_b = ap->sg_b + l * 256; const float* __restrict__ b_s = ap->b_s + l * 4 * 128;
    const int tid = fresh_tid(), lane = tid & 63, w = __builtin_amdgcn_readfirstlane(tid >> 6), r32 = lane & 31, hh = lane >> 5;
    {
        const int tok = tid >> 2, part = tid & 3;
        const bf16_t* rp = P + (size_t)(row0 + tok) * NIN + C_SGV + part * 64;
        float x[64]; float s = 0.f;
#pragma unroll
        for (int i = 0; i < 8; ++i) { const bf16x8 v = *(const bf16x8*)(rp + 8 * i);
#pragma unroll
            for (int e = 0; e < 8; ++e) { x[8 * i + e] = gelu_fast(bf2f(v[e])); s += x[8 * i + e]; } }
        s += xshf<1>(s); s += xshf<2>(s);
        const float mean = s * (1.f / 256.f); float s2 = 0.f;
#pragma unroll
        for (int e = 0; e < 64; ++e) { x[e] -= mean; s2 += x[e] * x[e]; }
        s2 += xshf<1>(s2); s2 += xshf<2>(s2);
        const float rstd = rsqrtf(s2 * (1.f / 256.f) + LN_EPS);
#pragma unroll
        for (int i = 0; i < 8; ++i) {
            const f32x4 g0 = *(const f32x4*)(sg_g + part * 64 + 8 * i), g1 = *(const f32x4*)(sg_g + part * 64 + 8 * i + 4), b0 = *(const f32x4*)(sg_b + part * 64 + 8 * i), b1 = *(const f32x4*)(sg_b + part * 64 + 8 * i + 4);
            float y[8];
#pragma unroll
            for (int e = 0; e < 4; ++e) { y[e] = x[8 * i + e] * rstd * g0[e] + b0[e]; y[4 + e] = x[8 * i + 4 + e] * rstd * g1[e] + b1[e]; }
            *(LAS bf16x8*)(lds + SG_V + tok * 576 + (part * 64 + 8 * i) * 2) = pack8(y);
        }
    }
    __syncthreads();
    const int pblk = w >> 1, dblk = w & 1;
    const int vtr = (8 * hh + ((lane & 15) >> 2)) * 576 + (dblk * 32 + 16 * ((lane >> 4) & 1) + 4 * (lane & 3)) * 2;
    for (int g = 0; g < 4; ++g) {
        const bf16_t* rq0 = P + (size_t)(row0 + (tid >> 3)) * NIN + g * 64 + (tid & 7) * 8; const bf16_t* rq1 = rq0 + (size_t)64 * NIN;
        const bf16x8 pu0 = *(const bf16x8*)(rq0 + C_SGU), pz0 = *(const bf16x8*)(rq0 + C_SGZ), pu1 = *(const bf16x8*)(rq1 + C_SGU), pz1 = *(const bf16x8*)(rq1 + C_SGZ);
        f32x16 acc;
#pragma unroll
        for (int r = 0; r < 16; ++r) acc[r] = 0.f;
        const bf16_t* wp = wsb + (size_t)g * 128 * 128 + (size_t)(pblk * 32 + r32) * 128 + 8 * hh;
#pragma unroll
        for (int ks = 0; ks < 8; ++ks) {
            const bf16x8 af = *(const bf16x8*)(wp + 16 * ks);
            const int off = SG_V + vtr + (16 * ks) * 576 + g * 128;
            const s16x4 lo = __builtin_bit_cast(s16x4, __builtin_amdgcn_ds_read_tr16_b64_v4i16((LAS s16x4*)(lds + off)));
            const s16x4 hi = __builtin_bit_cast(s16x4, __builtin_amdgcn_ds_read_tr16_b64_v4i16((LAS s16x4*)(lds + off + 4 * 576)));
            const bf16x8 bfr = {lo[0], lo[1], lo[2], lo[3], hi[0], hi[1], hi[2], hi[3]};
            acc = MFMA32(af, bfr, acc);
        }
#pragma unroll
        for (int r = 0; r < 16; ++r) { const int p = pblk * 32 + crow(r, hh); *(LAS float*)(lds + SG_YS + (p * 68 + dblk * 32 + r32) * 4) = acc[r] + b_s[g * 128 + p]; }
        __syncthreads();
#pragma unroll
        for (int i = 0; i < 2; ++i) {
            const int id = tid + 512 * i, p = id >> 3, ch = id & 7;
            const f32x4 v0 = *(const LAS f32x4*)(lds + SG_YS + (p * 68 + ch * 8) * 4), v1 = *(const LAS f32x4*)(lds + SG_YS + (p * 68 + ch * 8 + 4) * 4);
            const bf16x8 u = i ? pu1 : pu0, z = i ? pz1 : pz0;
            float y[8];
#pragma unroll
            for (int e = 0; e < 4; ++e) { y[e] = gelu_fast(bf2f(u[e])) * v0[e] * silu_f(bf2f(z[e])); y[4 + e] = gelu_fast(bf2f(u[4 + e])) * v1[e] * silu_f(bf2f(z[4 + e])); }
            *(bf16x8*)(mix + (size_t)(row0 + p) * DM + 768 + g * 64 + ch * 8) = pack8(y);
        }
        __syncthreads();
    }
}

constexpr int MQ_QS = 0, MQ_KS = 18432, MQ_HS = 80896, MQ_SM = 115712;
constexpr int MA_V = 36864, MA_KW = 61440;
constexpr int MC_V = 36864, MC_CB0 = 61440, MC_CB1 = 70656;
__device__ __forceinline__ int ml_rec(int pair, int dir, int cid) { return (pair * 2 + dir) * 18 + cid; }

__device__ __forceinline__ void mlstm_A(ldsp lds, int l, int pair, int cid) {
    const kargp_t ap = KARGS();
    const bf16_t* __restrict__ P = (const bf16_t*)(ap->ws + WS_P); bf16_t* __restrict__ QK = (bf16_t*)(ap->ws + WS_QK);
    const float* __restrict__ GATES = (const float*)(ap->ws + WS_GATES);
    float* __restrict__ CLOC = (float*)(ap->ws + WS_CLOC); float* __restrict__ NLOC = (float*)(ap->ws + WS_NLOC); float* __restrict__ SCL = (float*)(ap->ws + WS_SCL);
    const float* __restrict__ conv_w = ap->conv_w + (size_t)l * 3 * 512; const float* __restrict__ conv_b = ap->conv_b + l * 512;
    const int tid = fresh_tid(), lane = tid & 63, w = __builtin_amdgcn_readfirstlane(tid >> 6), r32 = lane & 31, hh = lane >> 5;
    const int b = pair >> 2, h = pair & 3;
    const bool isctx = cid < 2; const int cpos = isctx ? cid : cid - 2, L = isctx ? CTXL : SEQ, c0 = cpos * 128;
    const size_t seqrow = isctx ? (size_t)(ML + b * CTXL) : (size_t)b * SEQ;
    LAS float* GI = (LAS float*)(lds + MQ_SM); LAS float* GF = GI + 256; LAS float* WG2 = GI + 512;
    __syncthreads();
#pragma unroll
    for (int i = 0; i < 2; ++i) {
        const int id = tid + 512 * i, r = id >> 3, ch = id & 7, tt = c0 + r;
        const bf16_t* rp = P + (seqrow + tt) * NIN;
#pragma unroll
        for (int which = 0; which < 2; ++which) {
            const int colP = (which ? C_MLK : C_MLQ) + h * 64 + ch * 8, colW = (which ? 256 : 0) + h * 64 + ch * 8;
            const bf16x8 x0 = *(const bf16x8*)(rp + colP);
            bf16x8 xm = {0, 0, 0, 0, 0, 0, 0, 0}, xp = {0, 0, 0, 0, 0, 0, 0, 0};
            if (tt > 0) xm = *(const bf16x8*)(rp - NIN + colP);
            if (tt < L - 1) xp = *(const bf16x8*)(rp + NIN + colP);
            const f32x4 w0a = *(const f32x4*)(conv_w + colW), w0b = *(const f32x4*)(conv_w + colW + 4), w1a = *(const f32x4*)(conv_w + 512 + colW), w1b = *(const f32x4*)(conv_w + 512 + colW + 4);
            const f32x4 w2a = *(const f32x4*)(conv_w + 1024 + colW), w2b = *(const f32x4*)(conv_w + 1024 + colW + 4), cba = *(const f32x4*)(conv_b + colW), cbb = *(const f32x4*)(conv_b + colW + 4);
            float y[8];
#pragma unroll
            for (int e = 0; e < 8; ++e) {
                const float c0w = e < 4 ? w0a[e & 3] : w0b[e & 3], c1w = e < 4 ? w1a[e & 3] : w1b[e & 3], c2w = e < 4 ? w2a[e & 3] : w2b[e & 3], cbw = e < 4 ? cba[e & 3] : cbb[e & 3];
                float v = c0w * bf2f(xm[e]) + c1w * bf2f(x0[e]) + c2w * bf2f(xp[e]) + cbw;
                v = silu_f(v); if (which) v *= 0.125f; y[e] = v;
            }
            const bf16x8 pk = pack8(y);
            *(bf16x8*)(QK + (seqrow + tt) * 512 + which * 256 + h * 64 + ch * 8) = pk;
            if (which) *(LAS bf16x8*)(lds + MQ_KS + r * 144 + ch * 16) = pk;
        }
    }
#pragma unroll
    for (int i = 0; i < 2; ++i) {
        const int id = tid + 512 * i, r = id >> 3, ch = id & 7;
        *(LAS u32x4*)(lds + MA_V + r * 192 + ch * 16) = *(const u32x4*)(P + (seqrow + c0 + r) * NIN + C_MLV + h * 64 + ch * 8);
    }
    if (tid < 256) { const int dir = tid >> 7, s = tid & 127; const float* gp = GATES + (seqrow + c0 + s) * 16 + dir * 8 + h; GI[tid] = gp[0]; GF[tid] = logsigmoid_f(gp[4]); }
    __syncthreads();
    if (w < 2) {
        const int dir = w;
        const float f0 = GF[dir * 128 + 2 * lane], f1 = GF[dir * 128 + 2 * lane + 1], i0 = GI[dir * 128 + 2 * lane], i1 = GI[dir * 128 + 2 * lane + 1];
        const float s1 = f0 + f1; float x = s1;
#pragma unroll
        for (int off = 1; off < 64; off <<= 1) { const float y = lshf(x, lane - off); if (lane >= off) x += y; }
        const float tot = lshf(x, 63), ex = x - s1;
        const float b0 = dir ? tot - ex : ex + f0, b1 = dir ? tot - (ex + f0) : ex + s1;
        const float a0 = i0 - b0, a1 = i1 - b1;
        float sc_ = fmaxf(a0, a1), g0, g1;
        if (dir == 0) {
#pragma unroll
            for (int off = 1; off < 64; off <<= 1) { const float y = lshf(sc_, lane - off); if (lane >= off) sc_ = fmaxf(sc_, y); }
            float pe = lshf(sc_, lane - 1); if (lane == 0) pe = -3.0e38f;
            g0 = fmaxf(pe, a0); g1 = sc_;
        } else {
#pragma unroll
            for (int off = 1; off < 64; off <<= 1) { const float y = lshf(sc_, lane + off); if (lane + off < 64) sc_ = fmaxf(sc_, y); }
            float pe = lshf(sc_, lane + 1); if (lane == 63) pe = -3.0e38f;
            g1 = fmaxf(pe, a1); g0 = sc_;
        }
        const float mx = lshf(sc_, dir == 0 ? 63 : 0);
        { float* gp = (float*)(const_cast<bf16_t*>(P) + (seqrow + c0 + 2 * lane) * NIN + 4096) + (h * 2 + dir) * 4;
          *(f32x4*)gp = (f32x4){a0, b0, g0, 0.f}; *(f32x4*)(gp + NIN / 2) = (f32x4){a1, b1, g1, 0.f}; }
        WG2[dir * 128 + 2 * lane] = __expf(a0 - mx); WG2[dir * 128 + 2 * lane + 1] = __expf(a1 - mx);
        if (lane == 0) { float* sc = SCL + (size_t)ml_rec(pair, dir, cid) * 4; sc[0] = tot; sc[1] = tot + mx; }
    }
    __syncthreads();
#pragma unroll
    for (int i = 0; i < 2; ++i) {
        const int id = tid + 512 * i, r = id >> 3, ch = id & 7;
        const bf16x8 kv = *(const LAS bf16x8*)(lds + MQ_KS + r * 144 + ch * 16);
#pragma unroll
        for (int dir = 0; dir < 2; ++dir) {
            const float wg = WG2[dir * 128 + r]; float y[8];
#pragma unroll
            for (int e = 0; e < 8; ++e) y[e] = bf2f(kv[e]) * wg;
            *(LAS bf16x8*)(lds + MA_KW + dir * 24576 + r * 192 + ch * 16) = pack8(y);
        }
    }
    __syncthreads();
    {
        const int dir = w >> 2, vb = (w >> 1) & 1, kb = w & 1; const int rec = ml_rec(pair, dir, cid);
        const int trb = (8 * hh + ((lane & 15) >> 2)) * 192 + (16 * ((lane >> 4) & 1) + 4 * (lane & 3)) * 2;
        const short one = (r32 == 0) ? (short)0x3F80 : (short)0;
        const bf16x8 ones = {one, one, one, one, one, one, one, one};
        f32x16 cl, nl;
#pragma unroll
        for (int r = 0; r < 16; ++r) { cl[r] = 0.f; nl[r] = 0.f; }
#pragma unroll
        for (int ks = 0; ks < 8; ++ks) {
            const int ao = MA_V + trb + (16 * ks) * 192 + vb * 64, bo_ = MA_KW + dir * 24576 + trb + (16 * ks) * 192 + kb * 64;
            const s16x4 al = __builtin_bit_cast(s16x4, __builtin_amdgcn_ds_read_tr16_b64_v4i16((LAS s16x4*)(lds + ao))), ah = __builtin_bit_cast(s16x4, __builtin_amdgcn_ds_read_tr16_b64_v4i16((LAS s16x4*)(lds + ao + 4 * 192)));
            const s16x4 bl = __builtin_bit_cast(s16x4, __builtin_amdgcn_ds_read_tr16_b64_v4i16((LAS s16x4*)(lds + bo_))), bh = __builtin_bit_cast(s16x4, __builtin_amdgcn_ds_read_tr16_b64_v4i16((LAS s16x4*)(lds + bo_ + 4 * 192)));
            const bf16x8 af = {al[0], al[1], al[2], al[3], ah[0], ah[1], ah[2], ah[3]}, bfr = {bl[0], bl[1], bl[2], bl[3], bh[0], bh[1], bh[2], bh[3]};
            cl = MFMA32(af, bfr, cl);
            if (vb == 0) nl = MFMA32(ones, bfr, nl);
        }
        float* cp = CLOC + (size_t)rec * 4096;
#pragma unroll
        for (int r = 0; r < 16; ++r) cp[(vb * 32 + crow(r, hh)) * 64 + kb * 32 + r32] = cl[r];
        if (vb == 0 && hh == 0) NLOC[(size_t)rec * 64 + kb * 32 + r32] = nl[0];
    }
}

__device__ __forceinline__ void mlstm_B(int l, int pair, int dir) {
    const kargp_t ap = KARGS();
    const float* __restrict__ CLOC = (const float*)(ap->ws + WS_CLOC); const float* __restrict__ NLOC = (const float*)(ap->ws + WS_NLOC);
    float* __restrict__ SCL = (float*)(ap->ws + WS_SCL); bf16_t* __restrict__ CPREV = (bf16_t*)(ap->ws + WS_CPREV); float* __restrict__ NPREV = (float*)(ap->ws + WS_NPREV);
    const int tid = fresh_tid();
    float c[8]; float n = 0.f, m = 0.f;
#pragma unroll
    for (int e = 0; e < 8; ++e) c[e] = 0.f;
    for (int s0 = 0; s0 < 18; s0 += 6) {
        f32x4 l0[6], l1[6]; float nl[6], bend[6], mloc[6]; int rec[6];
#pragma unroll
        for (int u = 0; u < 6; ++u) {
            const int step = s0 + u; const bool isctx = step < 2; const int cidx = isctx ? step : step - 2, nch = isctx ? 2 : 16;
            const int cpos = (dir == 0) ? cidx : nch - 1 - cidx, cid = isctx ? cpos : 2 + cpos;
            rec[u] = ml_rec(pair, dir, cid);
            l0[u] = *(const f32x4*)(CLOC + (size_t)rec[u] * 4096 + tid * 8); l1[u] = *(const f32x4*)(CLOC + (size_t)rec[u] * 4096 + tid * 8 + 4);
            nl[u] = (tid < 64) ? NLOC[(size_t)rec[u] * 64 + tid] : 0.f;
            bend[u] = SCL[(size_t)rec[u] * 4]; mloc[u] = SCL[(size_t)rec[u] * 4 + 1];
        }
#pragma unroll
        for (int u = 0; u < 6; ++u) {
            *(bf16x8*)(CPREV + (size_t)rec[u] * 4096 + tid * 8) = pack8(c);
            if (tid < 64) NPREV[(size_t)rec[u] * 64 + tid] = n;
            if (tid == 0) SCL[(size_t)rec[u] * 4 + 2] = m;
            const float m_new = fmaxf(bend[u] + m, mloc[u]), fa = __expf(bend[u] + m - m_new), fs = __expf(mloc[u] - m_new);
#pragma unroll
            for (int e = 0; e < 4; ++e) { c[e] = fa * c[e] + fs * l0[u][e]; c[4 + e] = fa * c[4 + e] + fs * l1[u][e]; }
            n = fa * n + fs * nl[u]; m = m_new;
        }
    }
}

__device__ __forceinline__ void mlstm_C(ldsp lds, int l, int pair, int cid) {
    const kargp_t ap = KARGS();
    const bf16_t* __restrict__ P = (const bf16_t*)(ap->ws + WS_P); bf16_t* __restrict__ mix = (bf16_t*)(ap->ws + WS_HL); const bf16_t* __restrict__ QK = (const bf16_t*)(ap->ws + WS_QK);
    const float* __restrict__ SCL = (const float*)(ap->ws + WS_SCL); const bf16_t* __restrict__ CPREV = (const bf16_t*)(ap->ws + WS_CPREV); const float* __restrict__ NPREV = (const float*)(ap->ws + WS_NPREV);
    const float* __restrict__ ml_g = ap->ml_g + l * 256;
    const int tid = fresh_tid(), lane = tid & 63, w = __builtin_amdgcn_readfirstlane(tid >> 6), r32 = lane & 31, hh = lane >> 5;
    const int b = pair >> 2, h = pair & 3;
    const bool isctx = cid < 2; const int cpos = isctx ? cid : cid - 2, c0 = cpos * 128;
    const size_t seqrow = isctx ? (size_t)(ML + b * CTXL) : (size_t)b * SEQ;
    LAS float* GA = (LAS float*)(lds + MQ_SM);
    LAS float* GB = GA + 256;
    LAS float* GM = GA + 512;
    LAS float* NV = GA + 768;
    const int rec0 = ml_rec(pair, 0, cid), rec1 = ml_rec(pair, 1, cid);
    const float mp0 = SCL[(size_t)rec0 * 4 + 2], mp1 = SCL[(size_t)rec1 * 4 + 2];
    const bf16_t* rpe = P + (seqrow + c0 + (tid >> 2)) * NIN + h * 64 + (tid & 3) * 16;
    const bf16x8 o0 = *(const bf16x8*)(rpe + C_MLO), o1 = *(const bf16x8*)(rpe + C_MLO + 8), z0 = *(const bf16x8*)(rpe + C_MLZ), z1 = *(const bf16x8*)(rpe + C_MLZ + 8);
    __syncthreads();
#pragma unroll
    for (int i = 0; i < 2; ++i) {
        const int id = tid + 512 * i, r = id >> 3, ch = id & 7;
        const bf16_t* rp = QK + (seqrow + c0 + r) * 512 + h * 64 + ch * 8;
        *(LAS u32x4*)(lds + MQ_QS + r * 144 + ch * 16) = *(const u32x4*)rp;
        *(LAS u32x4*)(lds + MQ_KS + r * 144 + ch * 16) = *(const u32x4*)(rp + 256);
    }
#pragma unroll
    for (int i = 0; i < 2; ++i) {
        const int id = tid + 512 * i, r = id >> 3, ch = id & 7;
        *(LAS u32x4*)(lds + MC_V + r * 192 + ch * 16) = *(const u32x4*)(P + (seqrow + c0 + r) * NIN + C_MLV + h * 64 + ch * 8);
    }
    *(LAS u32x4*)(lds + MC_CB0 + (tid >> 3) * 144 + (tid & 7) * 16) = *(const u32x4*)(CPREV + (size_t)rec0 * 4096 + tid * 8);
    *(LAS u32x4*)(lds + MC_CB1 + (tid >> 3) * 144 + (tid & 7) * 16) = *(const u32x4*)(CPREV + (size_t)rec1 * 4096 + tid * 8);
    if (tid < 128) NV[tid] = NPREV[(size_t)(tid < 64 ? rec0 : rec1) * 64 + (tid & 63)];
    if (tid < 256) { const int dir = tid >> 7, tok = tid & 127;
        const f32x4 g = *(const f32x4*)((const float*)(P + (seqrow + c0 + tok) * NIN + 4096) + (h * 2 + dir) * 4);
        GA[tid] = g[0]; GB[tid] = g[1]; GM[tid] = g[2]; }
    __syncthreads();
    {
        const int jb = w & 3, vh = w >> 2, j = jb * 32 + r32;
        bf16x8 qf[4];
#pragma unroll
        for (int ks = 0; ks < 4; ++ks) qf[ks] = *(const LAS bf16x8*)(lds + MQ_QS + j * 144 + (16 * ks + 8 * hh) * 2);
        f32x16 tot;
#pragma unroll
        for (int r = 0; r < 16; ++r) tot[r] = 0.f;
#pragma unroll
        for (int dir = 0; dir < 2; ++dir) {
            const float m_state = dir ? mp1 : mp0;
            const float e_j = fmaxf(m_state, GM[dir * 128 + j]), b_j = GB[dir * 128 + j];
            f32x16 acc;
#pragma unroll
            for (int r = 0; r < 16; ++r) acc[r] = 0.f;
            float dsum = 0.f;
            const int sb_lo = dir ? jb : 0, sb_hi = dir ? 3 : jb;
            for (int sb = sb_lo; sb <= sb_hi; ++sb) {
                f32x16 st;
#pragma unroll
                for (int r = 0; r < 16; ++r) st[r] = 0.f;
#pragma unroll
                for (int ks = 0; ks < 4; ++ks) { const bf16x8 kf = *(const LAS bf16x8*)(lds + MQ_KS + (sb * 32 + r32) * 144 + (16 * ks + 8 * hh) * 2); st = MFMA32(kf, qf[ks], st); }
#pragma unroll
                for (int r = 0; r < 16; ++r) { const int s = sb * 32 + crow(r, hh); const float a_s = GA[dir * 128 + s];
                    const bool ok = dir ? (s >= j) : (s <= j);
                    const float val = ok ? st[r] * __expf(fminf(a_s - e_j, 0.f)) : 0.f; st[r] = val; dsum += val; }
#pragma unroll
                for (int s2 = 0; s2 < 2; ++s2) {
                    float pv[8];
#pragma unroll
                    for (int e = 0; e < 8; ++e) pv[e] = st[8 * s2 + e];
                    const bf16x8 bfrag = pack8(pv);
                    const int off = MC_V + (sb * 32 + 16 * s2 + 4 * hh + ((lane & 15) >> 2)) * 192 + (vh * 32 + 16 * ((lane >> 4) & 1) + 4 * (lane & 3)) * 2;
                    const s16x4 lo = __builtin_bit_cast(s16x4, __builtin_amdgcn_ds_read_tr16_b64_v4i16((LAS s16x4*)(lds + off))), hi = __builtin_bit_cast(s16x4, __builtin_amdgcn_ds_read_tr16_b64_v4i16((LAS s16x4*)(lds + off + 8 * 192)));
                    const bf16x8 afrag = {lo[0], lo[1], lo[2], lo[3], hi[0], hi[1], hi[2], hi[3]};
                    acc = MFMA32(afrag, bfrag, acc);
                }
            }
            f32x16 acc2;
#pragma unroll
            for (int r = 0; r < 16; ++r) acc2[r] = 0.f;
#pragma unroll
            for (int ks = 0; ks < 4; ++ks) { const bf16x8 cf = *(const LAS bf16x8*)(lds + (dir ? MC_CB1 : MC_CB0) + (vh * 32 + r32) * 144 + (16 * ks + 8 * hh) * 2); acc2 = MFMA32(cf, qf[ks], acc2); }
            const float w_int = __expf(m_state - e_j);
            float nq = 0.f;
#pragma unroll
            for (int ks = 0; ks < 4; ++ks)
#pragma unroll
                for (int e = 0; e < 8; ++e) nq += bf2f(qf[ks][e]) * NV[dir * 64 + 16 * ks + 8 * hh + e];
            nq += xshf<32>(nq); dsum += xshf<32>(dsum);
            const float den = w_int * nq + dsum;
            const float inv = 1.f / fmaxf(fabsf(den), __expf(-(b_j + e_j)));
#pragma unroll
            for (int r = 0; r < 16; ++r) tot[r] += (acc[r] + w_int * acc2[r]) * inv;
        }
#pragma unroll
        for (int r = 0; r < 16; ++r) *(LAS float*)(lds + MQ_HS + (j * 68 + vh * 32 + crow(r, hh)) * 4) = tot[r];
    }
    __syncthreads();
    {
        const int j = tid >> 2, qv = tid & 3; const size_t row = seqrow + c0 + j;
        float x[16]; float s = 0.f;
#pragma unroll
        for (int q4 = 0; q4 < 4; ++q4) {
            const f32x4 hs = *(const LAS f32x4*)(lds + MQ_HS + (j * 68 + qv * 16 + q4 * 4) * 4);
#pragma unroll
            for (int e = 0; e < 4; ++e) { const int idx = q4 * 4 + e; const float og = sigmoid_f(bf2f(idx < 8 ? o0[idx & 7] : o1[idx & 7])); x[idx] = og * hs[e]; s += x[idx]; }
        }
        s += xshf<1>(s); s += xshf<2>(s);
        const float mean = s * (1.f / 64.f); float s2 = 0.f;
#pragma unroll
        for (int e = 0; e < 16; ++e) { x[e] -= mean; s2 += x[e] * x[e]; }
        s2 += xshf<1>(s2); s2 += xshf<2>(s2);
        const float rstd = rsqrtf(s2 * (1.f / 64.f) + LN_EPS);
        float y[16];
#pragma unroll
        for (int e = 0; e < 16; ++e) y[e] = x[e] * rstd * ml_g[h * 64 + qv * 16 + e] * silu_f(bf2f(e < 8 ? z0[e & 7] : z1[e & 7]));
        bf16_t* mp = mix + row * DM + h * 64 + qv * 16;
        *(bf16x8*)mp = pack8(y); *(bf16x8*)(mp + 8) = pack8(y + 8);
    }
}

typedef unsigned int gu32_unused_t;
#define XB_TMO      128
#define XB_XCNT(j)  (256  + 64 * (j))
#define XB_XSUB(j)  (1280 + 64 * (j))
#define XB_XGEN(j)  (2304 + 64 * (j))
#define XB_TOP      3328
#define XB_TOPGEN   3392
#define XCD_BAR_WORDS 3456
#define XB_SPIN_CAP (1u << 18)

__device__ __forceinline__ unsigned xb_ld(unsigned* p)              { return __hip_atomic_load(p, __ATOMIC_RELAXED, __HIP_MEMORY_SCOPE_AGENT); }
__device__ __forceinline__ unsigned xb_add(unsigned* p, unsigned v) { return __hip_atomic_fetch_add(p, v, __ATOMIC_RELAXED, __HIP_MEMORY_SCOPE_AGENT); }
__device__ __forceinline__ unsigned xb_xcc_id() { return (unsigned)__builtin_amdgcn_s_getreg((3 << 11) | 20) & 0xFu; }
#define XB_SPIN(cond, bar) do { unsigned _sp = 0; while (cond) { __builtin_amdgcn_s_sleep(1); \
    if ((++_sp & 255u) == 0u) { if (xb_ld(&(bar)[XB_TMO])) break; if (_sp > XB_SPIN_CAP) { atomicAdd(&(bar)[XB_TMO], 1u); break; } } } } while (0)

struct XcdBarrier {
    unsigned* bar; unsigned x;
    volatile LAS unsigned* st;
};

__device__ __forceinline__ XcdBarrier xcd_barrier_post(unsigned* bar, volatile LAS unsigned* st) {
    XcdBarrier b; b.bar = bar; b.x = xb_xcc_id(); b.st = st;
    if (threadIdx.x == 0) (void)xb_add(&bar[XB_XCNT(b.x)], 1u);
    return b;
}
__device__ __forceinline__ void xcd_barrier_complete(unsigned* bar, unsigned x, unsigned& nloc, unsigned& nx) {
    const unsigned G = gridDim.x * gridDim.y * gridDim.z;
    unsigned sum, cnt, mine, sp = 0u;
    for (;;) {
        sum = 0u; cnt = 0u; mine = 0u;
#pragma unroll
        for (unsigned j = 0; j < 16; ++j) { const unsigned c = xb_ld(&bar[XB_XCNT(j)]); sum += c; cnt += (c > 0u) ? 1u : 0u; mine = (j == x) ? c : mine; }
        if (sum == G) break;
        __builtin_amdgcn_s_sleep(1);
        if ((++sp & 255u) == 0u) { if (xb_ld(&bar[XB_TMO])) break; if (sp > XB_SPIN_CAP) { atomicAdd(&bar[XB_TMO], 1u); break; } }
    }
    nloc = mine > 0u ? mine : 1u; nx = cnt > 0u ? cnt : 1u;
}

__device__ __forceinline__ void xcd_barrier(const XcdBarrier& b) {
    asm volatile("s_waitcnt vmcnt(0)" ::: "memory");
    __syncthreads();
    if (threadIdx.x == 0) {
        unsigned* bar = b.bar;
        __builtin_amdgcn_s_waitcnt(0);
        unsigned nloc = b.st[0], nx = b.st[1];
        if (nloc == 0u) { xcd_barrier_complete(bar, b.x, nloc, nx); b.st[0] = nloc; b.st[1] = nx; }
        const unsigned old = xb_add(&bar[XB_XSUB(b.x)], 1u);
        const unsigned gen = old / nloc;
        if (old + 1u == (gen + 1u) * nloc) {
            __builtin_amdgcn_fence(__ATOMIC_RELEASE, "agent");
            asm volatile("s_waitcnt vmcnt(0)" ::: "memory");
            const unsigned og = xb_add(&bar[XB_TOP], 1u);
            const unsigned tg = og / nx;
            if (og + 1u == (tg + 1u) * nx) xb_add(&bar[XB_TOPGEN], 1u);
            else XB_SPIN(xb_ld(&bar[XB_TOPGEN]) == tg, bar);
            __builtin_amdgcn_fence(__ATOMIC_ACQUIRE, "agent");
            xb_add(&bar[XB_XGEN(b.x)], 1u);
            asm volatile("s_waitcnt vmcnt(0)" ::: "memory");
        } else {
            XB_SPIN(xb_ld(&bar[XB_XGEN(b.x)]) == gen, bar);
            __builtin_amdgcn_fence(__ATOMIC_ACQUIRE, "agent");
            asm volatile("s_waitcnt vmcnt(0)" ::: "memory");
        }
    }
    __syncthreads();
}

template <int SP> __device__ __forceinline__ void mixer_sub(ldsp lds, int l, int rep, float lam, float lam_init) {
    const bool need_ctx = l < DEPTH - 1;
    unsigned* ctl; { const kargp_t ap = KARGS(); ctl = (unsigned*)(ap->ws + WS_CTL) + rep * 2048; }
    const int ncc = need_ctx ? 18 : 16;
    const int n_ac = need_ctx ? 32 : 0, n_c = 16 * ncc, n_sg = need_ctx ? 72 : 64;
    const int total = SP == 0 ? 128 + 288 : (SP == 1 ? 32 : 128 + n_ac + n_c + n_sg);
    volatile LAS int* slot = (volatile LAS int*)(lds + LDS_SLOT);
    const int myx = (int)(__builtin_amdgcn_s_getreg((3 << 11) | 20) & 7u);
    for (int k = 0; k < 8; ++k) {
        const int x = (myx + k) & 7;
        unsigned* ctr = ctl + ((l * 3 + SP) * 8 + x) * 16;
        for (;;) {
            __syncthreads();
            if (threadIdx.x == 0) *slot = (int)atomicAdd(ctr, 1u);
            __syncthreads();
            int it = *slot;
            it = __builtin_amdgcn_readfirstlane(it);
            if (it >= total) break;
            if (SP == 0) {
                if (it < 128) { const int pair = x * 16 + (it >> 4); attn_item(lds, l, pair >> 2, pair & 3, it & 15, false, lam, lam_init); continue; }
                it -= 128;
                mlstm_A(lds, l, x * 16 + it / 18, it % 18);
            } else if (SP == 1) {
                mlstm_B(l, x * 16 + (it >> 1), it & 1);
            } else {
                if (it < 128) { it += 128; const int pair = x * 16 + (it >> 4); attn_item(lds, l, pair >> 2, pair & 3, it & 15, false, lam, lam_init); continue; }
                it -= 128;
                if (it < n_ac) { const int pair = x * 16 + (it >> 1); attn_item(lds, l, pair >> 2, pair & 3, it & 1, true, lam, lam_init); continue; }
                it -= n_ac;
                if (it < n_sg) {
                    const int row0 = (it < 64) ? (4 * x + (it >> 4)) * SEQ + (it & 15) * 128 : ML + (4 * x + ((it - 64) >> 1)) * CTXL + ((it - 64) & 1) * 128;
                    sgu_item(lds, l, row0); continue; }
                it -= n_sg;
                mlstm_C(lds, l, x * 16 + it / ncc, (it % ncc) + (need_ctx ? 0 : 2));
            }
        }
    }
}
__device__ __forceinline__ void mixer_phase(ldsp lds, int l, const XcdBarrier& xb, int rep = 0) {
    float lam, lam_init;
    { const kargp_t ap = KARGS();
      float d1 = 0.f, d2 = 0.f;
      const float* q1 = ap->lq1 + l * 64; const float* k1 = ap->lk1 + l * 64; const float* q2 = ap->lq2 + l * 64; const float* k2 = ap->lk2 + l * 64;
      for (int i = 0; i < 64; ++i) { d1 += q1[i] * k1[i]; d2 += q2[i] * k2[i]; }
      lam_init = 0.8f - 0.6f * expf(-0.3f * (float)l);
      lam = expf(d1) - expf(d2) + lam_init; }
    mixer_sub<0>(lds, l, rep, lam, lam_init);
    xcd_barrier(xb);
    mixer_sub<1>(lds, l, rep, lam, lam_init);
    xcd_barrier(xb);
    mixer_sub<2>(lds, l, rep, lam, lam_init);
}

struct OrderLast {
    pg8::StaticOrder base; int G, c;
    __device__ void init(int G_, int c_) { base.init(ML, 4096, G_, c_); G = G_; c = c_; }
    __device__ bool next(int i, pg8::Unit& u) const {
        const int L = i * G + c;
        if (L < 4096) return base.next(i, u);
        const int r = L - 4096; if (r >= 32 * 6) return false;
        const int live[6] = {1, 2, 7, 8, 9, 10};
        const int j = r % 6; u.pm = ML / 256 + r / 6; u.pn = j == 0 ? 1 : j == 1 ? 2 : j == 2 ? 7 : j == 3 ? 8 : j == 4 ? 9 : 10; (void)live; return true;
    }
    __device__ __forceinline__ void a_ready(const pg8::Unit&) const {}
    __device__ __forceinline__ void done(const pg8::Unit&) const {}
};
typedef float f32x4g __attribute__((ext_vector_type(4)));
__device__ __forceinline__ void inproj_phase(ldsp lds, int l, int G) {
    const kargp_t ap = KARGS(); unsigned char* ws = ap->ws;
    {
        pg8::Gemm g{(const pg8::bf16_t*)(ws + WS_HL), (const pg8::bf16_t*)(ws + WS_WIN) + (size_t)l * NIN * 1024, MTOT, 4096, DM};
        pg8::EpiIn E{(pg8::bf16_t*)(ws + WS_P), (float*)(ws + WS_GATES), (const float*)(ws + WS_BIAS) + l * NIN, (const float*)(ws + WS_ROPE)};
        if (l == DEPTH - 1) {
            OrderLast S; S.init(G, (int)blockIdx.x);
            pg8::gemm_phase<pg8::EpiIn, OrderLast, true, true>(lds, g, S, E);
        } else {
            pg8::StaticOrder S; S.init(MTOT, 4096, G, (int)blockIdx.x);
            pg8::gemm_phase<pg8::EpiIn, pg8::StaticOrder, true, true>(lds, g, S, E);
        }
    }
    {
        const int tid = fresh_tid(), lane = tid & 63, w = tid >> 6, fr = lane & 15, fq = lane >> 4;
        const bf16_t* HL = (const bf16_t*)(ws + WS_HL); const bf16_t* WG = (const bf16_t*)(ws + WS_WIN) + ((size_t)l * NIN + 4096) * 1024;
        float* GATES = (float*)(ws + WS_GATES); const float bias = ((const float*)(ws + WS_BIAS))[l * NIN + 4096 + fr];
        for (int task = blockIdx.x * 8 + w; task < MTOT / 16; task += G * 8) {
            const bf16_t* ap_ = HL + (size_t)(task * 16 + fr) * DM + 8 * fq; const bf16_t* bp_ = WG + (size_t)fr * DM + 8 * fq;
            f32x4g acc = {0.f, 0.f, 0.f, 0.f};
#pragma unroll 8
            for (int kk = 0; kk < 32; ++kk) acc = __builtin_amdgcn_mfma_f32_16x16x32_bf16(*(const bf16x8*)(ap_ + kk * 32), *(const bf16x8*)(bp_ + kk * 32), acc, 0, 0, 0);
#pragma unroll
            for (int r = 0; r < 4; ++r) GATES[(size_t)(task * 16 + fq * 4 + r) * 16 + fr] = acc[r] + bias;
        }
    }
}
__device__ __forceinline__ void outproj_phase(ldsp lds, int l, int G) {
    const kargp_t ap = KARGS(); unsigned char* ws = ap->ws;
    const int Mo = (l == DEPTH - 1) ? ML : MTOT;
    pg8::Gemm g{(const pg8::bf16_t*)(ws + WS_HL), (const pg8::bf16_t*)(ws + WS_WOUT) + (size_t)l * 1024 * 1024, Mo, DM, DM};
    pg8::StaticOrder S; S.init(Mo, DM, G, (int)blockIdx.x);
    pg8::EpiOut E{l == 0 ? ap->x : ap->out, l == 0 ? ap->ctx : (const float*)(ws + WS_XC), ap->out, (float*)(ws + WS_XC), (const float*)(ws + WS_MOD) + (size_t)l * 33 * 3072 + 2048,
                  (const float*)(ws + WS_STATS), ap->ln_g + (l > 0 ? l - 1 : 0) * DM, ap->ln_b + (l > 0 ? l - 1 : 0) * DM, l > 0 ? 1 : 0};
    pg8::gemm_phase<pg8::EpiOut, pg8::StaticOrder, true, true>(lds, g, S, E);
}
template <int L> __device__ __forceinline__ void layer_body(ldsp lds, int G, const XcdBarrier& xb) {
    inproj_phase(lds, L, G);
    xcd_barrier(xb);
    mixer_phase(lds, L, xb);
    xcd_barrier(xb);
    outproj_phase(lds, L, G);
    xcd_barrier(xb);
    rowpass(L + 1, G);
    if (L + 1 < DEPTH) xcd_barrier(xb);
}
__global__ void __launch_bounds__(512, 2) fwd_kernel(Args a) {
    extern __shared__ __attribute__((aligned(16))) unsigned char lds_raw[];
    cg::grid_group grid = cg::this_grid();
    ldsp lds = (ldsp)lds_raw;
    const int G = gridDim.x;
    volatile LAS unsigned* xst = (volatile LAS unsigned*)(lds + LDS_SLOT + 32);
    if (threadIdx.x == 0) { xst[0] = 0u; xst[1] = 0u; }
    __syncthreads();
    const XcdBarrier xb = xcd_barrier_post((unsigned*)(a.ws + WS_CTL) + 8192, xst);
    prologue(lds, G);
    grid.sync();
    rowpass(0, G);
    xcd_barrier(xb);
    layer_body<0>(lds, G, xb); layer_body<1>(lds, G, xb); layer_body<2>(lds, G, xb); layer_body<3>(lds, G, xb);
}

extern "C" void kernel_launch(void* const* d_in, const int* in_sizes, int n_in, void* d_out, int out_size, void* d_ws, size_t ws_size, hipStream_t stream) {
    static int grid = 0;
    if (grid == 0) {
        int dev = 0, cus = 0, per_cu = 0;
        if (hipGetDevice(&dev) != hipSuccess || hipDeviceGetAttribute(&cus, hipDeviceAttributeMultiprocessorCount, dev) != hipSuccess) { fprintf(stderr, "device query failed\n"); grid = -1; return; }
        if (hipFuncSetAttribute((const void*)fwd_kernel, hipFuncAttributeMaxDynamicSharedMemorySize, LDS_BYTES) != hipSuccess) { fprintf(stderr, "hipFuncSetAttribute failed\n"); grid = -1; return; }
        if (hipOccupancyMaxActiveBlocksPerMultiprocessor(&per_cu, (const void*)fwd_kernel, 512, LDS_BYTES) != hipSuccess || per_cu < 1) fprintf(stderr, "occupancy query: %d\n", per_cu);
        (void)hipGetLastError();
        if (ws_size < WS_END) { fprintf(stderr, "workspace too small: %zu < %zu\n", ws_size, (size_t)WS_END); grid = -1; return; }
        grid = cus;
    }
    if (grid < 0) return;
    (void)hipMemsetAsync((char*)d_ws + WS_CTL, 0, CTL_BYTES, stream);
    Args a{};
    const float** ap = (const float**)&a;
    for (int i = 0; i < 23; ++i) ap[i] = (const float*)d_in[i];
    a.out = (float*)d_out; a.ws = (unsigned char*)d_ws;
    void* args[] = {&a};
    hipError_t e = hipLaunchCooperativeKernel((const void*)fwd_kernel, dim3(grid), dim3(512), args, LDS_BYTES, stream);
    if (e != hipSuccess) fprintf(stderr, "cooperative launch failed: %s (grid %d)\n", hipGetErrorString(e), grid);
}
```

```cpp
#include <hip/hip_runtime.h>
#include <hip/hip_cooperative_groups.h>
#include <cstdio>
#include <cstdint>
namespace cg = cooperative_groups;

constexpr int DM = 1024, NBATCH = 32, SEQ = 2048, CTXL = 256, DEPTH = 4;
constexpr int ML = NBATCH * SEQ, MCX = NBATCH * CTXL, MTOT = ML + MCX;
constexpr int NIN = 4352, NINR = 4112;
constexpr int C_MLQ = 0, C_MLK = 256, C_MLV = 512, C_MLO = 768, C_MLZ = 1024, C_DAQ = 1280, C_DAK = 1792, C_DAV = 2304, C_DAZ = 2816,
              C_SGU = 3328, C_SGV = 3584, C_SGZ = 3840, C_GATE = 4096;
constexpr float LN_EPS = 1e-5f;
constexpr float DN_ALPHA = 1.681792830507429f;
constexpr float QSCALE = 0.125f * 1.4426950408889634f;

template <int O> __device__ __forceinline__ float xshf(float v) {
    if constexpr (O < 32) { return __int_as_float(__builtin_amdgcn_ds_swizzle(__float_as_int(v), (O << 10) | 0x1f)); }
    else { const auto r = __builtin_amdgcn_permlane32_swap(__float_as_uint(v), __float_as_uint(v), false, false);
           return __uint_as_float((threadIdx.x & 32) ? r[0] : r[1]); }
}
__device__ __forceinline__ float lshf(float v, int src_lane) { return __int_as_float(__builtin_amdgcn_ds_bpermute(src_lane << 2, __float_as_int(v))); }
namespace pg8 {
#define PG8_LAS __attribute__((address_space(3)))
typedef unsigned short bf16_t;
typedef short bf16x8 __attribute__((ext_vector_type(8)));
typedef float f32x4 __attribute__((ext_vector_type(4)));
typedef unsigned u32x4 __attribute__((ext_vector_type(4)));
constexpr int BM = 256, BK = 64, HALF = 128, HTB = HALF * BK * 2  , STAGE_BYTES = 8 * HTB, NXCD = 8, WGM = 8;

__host__ __device__ __forceinline__ int lds_byte(int r, int c) { const int st = (r >> 4) * 2 + (c >> 5), rr = r & 15, cc = c & 31, ob = rr * 64 + cc * 2; return st * 1024 + (ob ^ (((ob >> 9) & 1) << 5)); }
__host__ __device__ __forceinline__ void stage_rc(int b, int& R, int& C) { const int st = b / 1024, sb = b % 1024, swz = sb ^ (((sb >> 9) & 1) << 5); R = (st >> 1) * 16 + swz / 64; C = (st & 1) * 32 + (swz % 64) / 2; }
__host__ __device__ __forceinline__ int perm32(int rho) { const int n = rho >> 4, i = rho & 15; return 8 * (i >> 2) + 4 * n + (i & 3); }

struct Unit { int pm, pn; };
struct Gemm { const bf16_t* A; const bf16_t* Bt; int M, N, K; };

struct StaticOrder {
    int nM, nN, nwg, G, c;
    __host__ __device__ void init(int M, int N, int G_, int c_) { nM = M / BM; nN = N / BM; nwg = nM * nN; G = G_; c = c_; }
    __host__ __device__ bool next(int i, Unit& u) const {
        const long L = (long)i * G + c; if (L >= nwg) return false;
        int wgid = (int)L; { const int q = nwg / NXCD, r = nwg % NXCD, xcd = wgid % NXCD, off = wgid / NXCD; wgid = (xcd < r ? xcd * (q + 1) : r * (q + 1) + (xcd - r) * q) + off; }
        const int nig = WGM * nN, gid = wgid / nig, fm = gid * WGM, gsz = (nM - fm) < WGM ? (nM - fm) : WGM;
        u.pm = fm + ((wgid % nig) % gsz); u.pn = (wgid % nig) / gsz; return true;
    }
    __device__ __forceinline__ void a_ready(const Unit&) const {}
    __device__ __forceinline__ void done(const Unit&) const {}
};
__device__ __forceinline__ unsigned cvt_pk_bf16(float lo, float hi) { unsigned r; asm volatile("v_cvt_pk_bf16_f32 %0, %1, %2" : "=v"(r) : "v"(lo), "v"(hi)); return r; }
typedef float f32x2 __attribute__((ext_vector_type(2)));
typedef float f32x2 __attribute__((ext_vector_type(2)));
struct EpiIn {
    static constexpr bool PERM = true, AFTER_DRAIN = false;
    bf16_t* P; float* GATES; const float* bias; const float* rope;
    __device__ __forceinline__ void operator()(const f32x4 (&acc)[2][2][4][2], const Unit& u, int wr, int wc, int fr, int fq) const {
        const int row0 = u.pm * BM + wr * 64 + fr, colt = u.pn * BM, col0 = colt + wc * 32 + 8 * fq;
        const bool is_lat = u.pm < (ML / BM);
        const int mode = (u.pn == 5 || u.pn == 6) ? 1 : ((u.pn == 7 || u.pn == 8) ? 2 : (u.pn == 16 ? 3 : 0));
        const bool do_rope = (mode == 1 || mode == 2) && is_lat;
        const float sgn = (fq < 2) ? -1.f : 1.f;
        f32x4 bv[2][2];
#pragma unroll
        for (int bj = 0; bj < 2; ++bj)
#pragma unroll
            for (int n = 0; n < 2; ++n) bv[bj][n] = *(const f32x4*)(bias + col0 + bj * HALF + 4 * n);
#pragma unroll
        for (int ai = 0; ai < 2; ++ai)
#pragma unroll
            for (int m = 0; m < 4; ++m) {
                const int row = row0 + ai * HALF + m * 16;
                const int t = row & (SEQ - 1);
                const int pidx = (wc & 1) ? 32 + (t & 63) : (t >> 6);
                const float* tab = rope + (pidx * 16 + 8 * (fq & 1)) * 2;
#pragma unroll
                for (int bj = 0; bj < 2; ++bj) {
                    f32x4 v0 = acc[ai][bj][m][0] + bv[bj][0], v1 = acc[ai][bj][m][1] + bv[bj][1];
                    if (mode == 1 || mode == 2) {
                        f32x4 p0, p1;
#pragma unroll
                        for (int e = 0; e < 4; ++e) { p0[e] = xshf<32>(v0[e]); p1[e] = xshf<32>(v1[e]); }
                        if (do_rope) {
                            const f32x4 t0 = *(const f32x4*)(tab), t1 = *(const f32x4*)(tab + 4), t2 = *(const f32x4*)(tab + 8), t3 = *(const f32x4*)(tab + 12);
                            v0[0] = v0[0] * t0[0] + sgn * p0[0] * t0[1]; v0[1] = v0[1] * t0[2] + sgn * p0[1] * t0[3];
                            v0[2] = v0[2] * t1[0] + sgn * p0[2] * t1[1]; v0[3] = v0[3] * t1[2] + sgn * p0[3] * t1[3];
                            v1[0] = v1[0] * t2[0] + sgn * p1[0] * t2[1]; v1[1] = v1[1] * t2[2] + sgn * p1[1] * t2[3];
                            v1[2] = v1[2] * t3[0] + sgn * p1[2] * t3[1]; v1[3] = v1[3] * t3[2] + sgn * p1[3] * t3[3];
                        }
                        if (mode == 1) { v0 = v0 * QSCALE; v1 = v1 * QSCALE; }
                    }
                    if (mode == 3) {
                        if (wc == 0 && bj == 0 && fq < 2) { float* gp = GATES + (size_t)row * 16 + 8 * fq; *(f32x4*)gp = v0; *(f32x4*)(gp + 4) = v1; }
                    } else {
                        u32x4 w; w.x = cvt_pk_bf16(v0[0], v0[1]); w.y = cvt_pk_bf16(v0[2], v0[3]); w.z = cvt_pk_bf16(v1[0], v1[1]); w.w = cvt_pk_bf16(v1[2], v1[3]);
                        *(u32x4*)(P + (size_t)row * NIN + col0 + bj * HALF) = w;
                    }
                }
            }
    }
};
struct EpiOut {
    static constexpr bool PERM = false, AFTER_DRAIN = false;
    const float* src_lat; const float* src_ctx; float* dst_lat; float* dst_ctx; const float* gate;
    const float* stats; const float* lng; const float* lnb; int use_ln;
    __device__ __forceinline__ void operator()(const f32x4 (&acc)[2][2][4][2], const Unit& u, int wr, int wc, int fr, int fq) const {
        const int rowt = u.pm * BM; const bool is_lat = u.pm < (ML / BM);
        const int bidx = is_lat ? (rowt >> 11) : 32;
        const float* src = is_lat ? src_lat + (size_t)rowt * DM : src_ctx + (size_t)(rowt - ML) * DM;
        float* dst = is_lat ? dst_lat + (size_t)rowt * DM : dst_ctx + (size_t)(rowt - ML) * DM;
        const int col0 = u.pn * BM + wc * 32 + 4 * fq;
        const float* g = gate + (size_t)bidx * 3072;
        f32x4 gv[2][2], lg[2][2], lb[2][2];
#pragma unroll
        for (int bj = 0; bj < 2; ++bj)
#pragma unroll
            for (int n = 0; n < 2; ++n) { gv[bj][n] = *(const f32x4*)(g + col0 + bj * HALF + n * 16);
                if (use_ln) { lg[bj][n] = *(const f32x4*)(lng + col0 + bj * HALF + n * 16); lb[bj][n] = *(const f32x4*)(lnb + col0 + bj * HALF + n * 16); }
                else { lg[bj][n] = (f32x4){1.f, 1.f, 1.f, 1.f}; lb[bj][n] = (f32x4){0.f, 0.f, 0.f, 0.f}; } }
#pragma unroll
        for (int ai = 0; ai < 2; ++ai)
#pragma unroll
            for (int m = 0; m < 4; ++m) {
                const int r = ai * HALF + wr * 64 + m * 16 + fr;
                const size_t off = (size_t)r * DM + col0;
                float mean = 0.f, rstd = 1.f;
                if (use_ln) { const f32x2 st = *(const f32x2*)(stats + (size_t)(rowt + r) * 2); mean = st.x; rstd = st.y; }
#pragma unroll
                for (int bj = 0; bj < 2; ++bj)
#pragma unroll
                    for (int n = 0; n < 2; ++n) {
                        const f32x4 rv = *(const f32x4*)(src + off + bj * HALF + n * 16);
                        const f32x4 xv = (rv - mean) * rstd * lg[bj][n] + lb[bj][n];
                        *(f32x4*)(dst + off + bj * HALF + n * 16) = xv * DN_ALPHA + gv[bj][n] * acc[ai][bj][m][n];
                    }
            }
    }
};
template <class Epi, class Sched, bool ALIGN_EPI = false, bool SP2 = false>
__device__ __forceinline__ void gemm_phase(PG8_LAS unsigned char* lds, const Gemm g, const Sched& S, const Epi& E) {
    int tid_l = threadIdx.x; asm volatile("" : "+v"(tid_l));
    const int tid = tid_l, wid = __builtin_amdgcn_readfirstlane(tid >> 6), lane = tid & 63, wr = wid >> 2, wc = wid & 3, fr = lane & 15, fq = lane >> 4;
    const int K = g.K, nt = K / BK;
    unsigned voffA[2], voffB[2];
#pragma unroll
    for (int i = 0; i < 2; ++i) { int R, C; stage_rc(tid * 16 + i * 8192, R, C); const int Rb = Epi::PERM ? ((R & ~31) + perm32(R & 31)) : R;
        voffA[i] = (unsigned)(R * K + C) * 2u; voffB[i] = (unsigned)(Rb * K + C) * 2u; }
    const size_t kstep = (size_t)(BK * 2);
    const size_t hstep = (size_t)HALF * K * 2;
    const size_t tstep = 2 * hstep;
    const unsigned ldsw = (unsigned)wid * 1024u;
    const int aoff = lds_byte(wr * 64 + fr, fq * 8), boff = lds_byte(wc * 32 + fr, fq * 8);
#define PG8_SA(b, h) (((b) * 2 + (h)) * HTB)
#define PG8_SB(b, h) ((4 + (b) * 2 + (h)) * HTB)
#define PG8_STAGE(bufoff, gbase, voff) do { _Pragma("unroll") for (int _i = 0; _i < 2; ++_i) \
        __builtin_amdgcn_global_load_lds((const unsigned*)((const char*)(gbase) + (voff)[_i]), (PG8_LAS unsigned*)(lds + (bufoff) + ldsw + _i * 8192), 16, 0, 0); } while (0)
#define PG8_LDA(dst, b, h) do { _Pragma("unroll") for (int m = 0; m < 4; ++m) _Pragma("unroll") for (int k = 0; k < 2; ++k) dst[m][k] = *(const PG8_LAS bf16x8*)(lds + PG8_SA(b, h) + aoff + m * 2048 + k * 1024); } while (0)
#define PG8_LDB(dst, b, h) do { _Pragma("unroll") for (int n = 0; n < 2; ++n) _Pragma("unroll") for (int k = 0; k < 2; ++k) dst[n][k] = *(const PG8_LAS bf16x8*)(lds + PG8_SB(b, h) + boff + n * 2048 + k * 1024); } while (0)
#define PG8_MMA(ai, bj, At, Bt) do { __builtin_amdgcn_s_setprio(1); _Pragma("unroll") for (int m = 0; m < 4; ++m) _Pragma("unroll") for (int n = 0; n < 2; ++n) _Pragma("unroll") for (int k = 0; k < 2; ++k) \
        acc[ai][bj][m][n] = __builtin_amdgcn_mfma_f32_16x16x32_bf16(Bt[n][k], At[m][k], acc[ai][bj][m][n], 0, 0, 0); __builtin_amdgcn_s_setprio(0); } while (0)
#define PG8_WAIT_V(n) asm volatile("s_waitcnt vmcnt(" #n ")" ::: "memory")
#define PG8_WAIT_L(n) asm volatile("s_waitcnt lgkmcnt(" #n ")" ::: "memory")
#define PG8_BAR __builtin_amdgcn_s_barrier()
#define PG8_SCHED __builtin_amdgcn_sched_barrier(0)
    Unit cur, nxt; int ui = 0;
    if (!S.next(0, cur)) return;
    f32x4 acc[2][2][4][2];
#pragma unroll
    for (int a = 0; a < 2; ++a)
#pragma unroll
        for (int b = 0; b < 2; ++b)
#pragma unroll
            for (int m = 0; m < 4; ++m)
#pragma unroll
                for (int n = 0; n < 2; ++n) acc[a][b][m][n] = (f32x4){0.f, 0.f, 0.f, 0.f};
    bf16x8 At[4][2], B0[2][2], B1[2][2];
    const char* cA = (const char*)g.A + (size_t)cur.pm * tstep; const char* cB = (const char*)g.Bt + (size_t)cur.pn * tstep;
    S.a_ready(cur);
    if constexpr (SP2) {
        PG8_STAGE(PG8_SB(0, 0), cB, voffB); PG8_STAGE(PG8_SB(0, 1), cB + hstep, voffB); PG8_STAGE(PG8_SA(0, 0), cA, voffA); PG8_STAGE(PG8_SA(0, 1), cA + hstep, voffA);
        if (wr == 1) PG8_BAR;
        PG8_WAIT_V(2); PG8_BAR;
        PG8_STAGE(PG8_SB(1, 0), cB + kstep, voffB); PG8_STAGE(PG8_SA(1, 0), cA + kstep, voffA); PG8_STAGE(PG8_SB(1, 1), cB + hstep + kstep, voffB);
        PG8_WAIT_V(6); PG8_BAR;
    } else {
        PG8_STAGE(PG8_SB(0, 0), cB, voffB); PG8_STAGE(PG8_SA(0, 0), cA, voffA); PG8_STAGE(PG8_SB(0, 1), cB + hstep, voffB); PG8_STAGE(PG8_SA(0, 1), cA + hstep, voffA);
        if (wr == 1) PG8_BAR;
        PG8_WAIT_V(4); PG8_BAR;
        PG8_STAGE(PG8_SB(1, 0), cB + kstep, voffB); PG8_STAGE(PG8_SA(1, 0), cA + kstep, voffA); PG8_STAGE(PG8_SB(1, 1), cB + hstep + kstep, voffB);
        PG8_WAIT_V(6); PG8_BAR;
    }
    for (;;) {
        const bool has_next = S.next(ui + 1, nxt);
        const char* nA = has_next ? (const char*)g.A + (size_t)nxt.pm * tstep : cA; const char* nB = has_next ? (const char*)g.Bt + (size_t)nxt.pn * tstep : cB;
        for (int t = 0; t < nt; t += 2) {
            const bool last = (t == nt - 2);
            const char* a1 = cA + (size_t)(t + 1) * kstep;
            const char* a2 = last ? nA : cA + (size_t)(t + 2) * kstep; const char* b2 = last ? nB : cB + (size_t)(t + 2) * kstep;
            const char* a3 = a2 + kstep; const char* b3 = b2 + kstep;
            if (last && has_next) S.a_ready(nxt);
            if constexpr (SP2) {
            PG8_LDB(B0, 0, 0); PG8_LDB(B1, 0, 1); PG8_SCHED; PG8_LDA(At, 0, 0); PG8_STAGE(PG8_SA(1, 1), a1 + hstep, voffA);
            PG8_WAIT_V(8); PG8_WAIT_L(0); PG8_BAR; PG8_MMA(0, 0, At, B0); PG8_MMA(0, 1, At, B1); PG8_BAR; PG8_SCHED;
            PG8_LDA(At, 0, 1); PG8_STAGE(PG8_SB(0, 0), b2, voffB); PG8_STAGE(PG8_SB(0, 1), b2 + hstep, voffB); PG8_STAGE(PG8_SA(0, 0), a2, voffA);
            PG8_WAIT_V(8); PG8_WAIT_L(0); PG8_BAR; PG8_MMA(1, 0, At, B0); PG8_MMA(1, 1, At, B1); PG8_BAR; PG8_SCHED;
            PG8_LDB(B0, 1, 0); PG8_LDB(B1, 1, 1); PG8_SCHED; PG8_LDA(At, 1, 0); PG8_STAGE(PG8_SA(0, 1), a2 + hstep, voffA);
            PG8_WAIT_V(8); PG8_WAIT_L(0); PG8_BAR; PG8_MMA(0, 0, At, B0); PG8_MMA(0, 1, At, B1); PG8_BAR; PG8_SCHED;
            PG8_LDA(At, 1, 1); PG8_STAGE(PG8_SB(1, 0), b3, voffB); PG8_STAGE(PG8_SB(1, 1), b3 + hstep, voffB); PG8_STAGE(PG8_SA(1, 0), a3, voffA);
            PG8_WAIT_V(8); PG8_WAIT_L(0); PG8_BAR; PG8_MMA(1, 0, At, B0); PG8_MMA(1, 1, At, B1); PG8_BAR; PG8_SCHED;
            } else {
            PG8_LDB(B0, 0, 0); PG8_SCHED; PG8_LDA(At, 0, 0); PG8_STAGE(PG8_SA(1, 1), a1 + hstep, voffA);
            PG8_WAIT_L(8); PG8_BAR; PG8_WAIT_L(0); PG8_MMA(0, 0, At, B0); PG8_BAR; PG8_SCHED;
            PG8_LDB(B1, 0, 1); PG8_STAGE(PG8_SB(0, 0), b2, voffB);
            PG8_BAR; PG8_WAIT_L(0); PG8_MMA(0, 1, At, B1); PG8_BAR;
            PG8_LDA(At, 0, 1); PG8_STAGE(PG8_SA(0, 0), a2, voffA);
            PG8_BAR; PG8_WAIT_L(0); PG8_MMA(1, 0, At, B0); PG8_BAR; PG8_SCHED;
            PG8_STAGE(PG8_SB(0, 1), b2 + hstep, voffB);
            PG8_WAIT_V(6); PG8_BAR; PG8_MMA(1, 1, At, B1); PG8_BAR;
            PG8_LDB(B0, 1, 0); PG8_SCHED; PG8_LDA(At, 1, 0); PG8_STAGE(PG8_SA(0, 1), a2 + hstep, voffA);
            PG8_WAIT_L(8); PG8_BAR; PG8_WAIT_L(0); PG8_MMA(0, 0, At, B0); PG8_BAR; PG8_SCHED;
            PG8_LDB(B1, 1, 1); PG8_STAGE(PG8_SB(1, 0), b3, voffB);
            PG8_BAR; PG8_WAIT_L(0); PG8_MMA(0, 1, At, B1); PG8_BAR;
            PG8_LDA(At, 1, 1); PG8_STAGE(PG8_SA(1, 0), a3, voffA);
            PG8_BAR; PG8_WAIT_L(0); PG8_MMA(1, 0, At, B0); PG8_BAR; PG8_SCHED;
            PG8_STAGE(PG8_SB(1, 1), b3 + hstep, voffB);
            PG8_WAIT_V(6); PG8_BAR; PG8_MMA(1, 1, At, B1); PG8_BAR;
            }
        }
        if constexpr (ALIGN_EPI) { if (wr == 0) PG8_BAR; }
        if constexpr (!Epi::AFTER_DRAIN) { E(acc, cur, wr, wc, fr, fq); S.done(cur); }
        if (!has_next) break;
#pragma unroll
        for (int a = 0; a < 2; ++a)
#pragma unroll
            for (int b = 0; b < 2; ++b)
#pragma unroll
                for (int m = 0; m < 4; ++m)
#pragma unroll
                    for (int n = 0; n < 2; ++n) acc[a][b][m][n] = (f32x4){0.f, 0.f, 0.f, 0.f};
        cur = nxt; cA = nA; cB = nB; ++ui;
        if constexpr (ALIGN_EPI) { if (wr == 1) PG8_BAR; }
    }
    PG8_WAIT_V(0);
    if constexpr (!ALIGN_EPI) { if (wr == 0) PG8_BAR; }
    PG8_BAR;
    if constexpr (Epi::AFTER_DRAIN) { E.fused(acc, cur, wr, wc, fr, fq, lds, wid, lane); S.done(cur); }
#undef PG8_SA
#undef PG8_SB
#undef PG8_STAGE
#undef PG8_LDA
#undef PG8_LDB
#undef PG8_MMA
#undef PG8_WAIT_V
#undef PG8_WAIT_L
#undef PG8_BAR
#undef PG8_SCHED
}
}

#define LAS __attribute__((address_space(3)))
typedef unsigned short bf16_t;
typedef short bf16x8 __attribute__((ext_vector_type(8)));
typedef short s16x4 __attribute__((ext_vector_type(4)));
typedef float f32x4 __attribute__((ext_vector_type(4)));
typedef float f32x16 __attribute__((ext_vector_type(16)));
typedef unsigned u32x4 __attribute__((ext_vector_type(4)));
typedef unsigned u32x2 __attribute__((ext_vector_type(2)));
typedef LAS unsigned char* ldsp;

__device__ __forceinline__ float bf2f(short b) { return __uint_as_float(((unsigned)(unsigned short)b) << 16); }
__device__ __forceinline__ unsigned short f2bf(float f) { const unsigned u = __float_as_uint(f); return (unsigned short)((u + 0x7fffu + ((u >> 16) & 1u)) >> 16); }
typedef float f32x2_t __attribute__((ext_vector_type(2))); typedef __bf16 bf16x2_t __attribute__((ext_vector_type(2)));
__device__ __forceinline__ unsigned pk2(float lo, float hi) { f32x2_t v = {lo, hi}; bf16x2_t b = __builtin_convertvector(v, bf16x2_t); return __builtin_bit_cast(unsigned, b); }
__device__ __forceinline__ float silu_f(float x) { return x / (1.f + __expf(-x)); }
__device__ __forceinline__ float sigmoid_f(float x) { return 1.f / (1.f + __expf(-x)); }
__device__ __forceinline__ float gelu_f(float x) { return 0.5f * x * (1.f + erff(x * 0.70710678118654752f)); }
__device__ __forceinline__ float gelu_fast(float v) {
    const float av = fabsf(v), d = av * 0.2316418882f + 1.0f, t = __builtin_amdgcn_rcpf(d);
    float q = t * 0.5307027145f + (-0.7265760135f); q = q * t + 0.7107068705f; q = q * t + (-0.142248368f); q = q * t + 0.127414796f; q = q * t;
    const float e = __builtin_amdgcn_exp2f((v * v) * (-0.72134752044f));
    const float m = v * (q * e), r = v - m; return v < 0.f ? m : r;
}
__device__ __forceinline__ float logsigmoid_f(float x) { return fminf(x, 0.f) - log1pf(expf(-fabsf(x))); }
__device__ __forceinline__ float wave_sum(float v) {
    v += xshf<1>(v); v += xshf<2>(v); v += xshf<4>(v); v += xshf<8>(v); v += xshf<16>(v); v += xshf<32>(v);
    return v;
}
__device__ __forceinline__ bf16x8 pack8(const float* v) {
    u32x4 w; w.x = pk2(v[0], v[1]); w.y = pk2(v[2], v[3]); w.z = pk2(v[4], v[5]); w.w = pk2(v[6], v[7]);
    return __builtin_bit_cast(bf16x8, w);
}
#define MFMA32(a, b, c) __builtin_amdgcn_mfma_f32_32x32x16_bf16((a), (b), (c), 0, 0, 0)
__device__ __forceinline__ int crow(int r, int hh) { return (r & 3) + 8 * (r >> 2) + 4 * hh; }

constexpr size_t MiB = 1u << 20;
constexpr size_t WS_CTL = 0, CTL_BYTES = 65536;
constexpr size_t WS_MOD = 1 * MiB;
constexpr size_t WS_BIAS = 3 * MiB;
constexpr size_t WS_ROPE = 3 * MiB + 512 * 1024;
constexpr size_t WS_WOUT = 4 * MiB;
constexpr size_t WS_WIN = 12 * MiB;
constexpr size_t WS_XC = 46 * MiB;
constexpr size_t WS_HL = 78 * MiB;
constexpr size_t WS_CLOC = 222 * MiB;
constexpr size_t WS_P = 294 * MiB;
constexpr size_t WS_GATES = 906 * MiB;
constexpr size_t WS_WSB2 = 912 * MiB;
constexpr size_t WS_QK = 914 * MiB;
constexpr size_t WS_CPREV = 986 * MiB;
constexpr size_t WS_NLOC = 910 * MiB + 512 * 1024;
constexpr size_t WS_NPREV = 912 * MiB + 512 * 1024;
constexpr size_t WS_SCL = 913 * MiB + 768 * 1024;
constexpr size_t WS_GARR = 3 * MiB + 640 * 1024;
constexpr size_t WS_STATS = 1022 * MiB;
constexpr size_t WS_END = 1023 * MiB;

constexpr int LDS_BYTES = 147456;
constexpr int LDS_SLOT = LDS_BYTES - 64;

struct Args {
    const float *x, *c, *ctx, *c_ctx, *w_mod, *b_mod, *w_in, *b_in, *conv_w, *conv_b, *ml_g, *lq1, *lk1, *lq2, *lk2, *da_g, *sg_g, *sg_b, *w_s, *b_s, *w_out, *ln_g, *ln_b;
    float* out; unsigned char* ws;
};


typedef const __attribute__((address_space(4))) struct Args* kargp_t;
#define KARGS() ({ kargp_t p_ = (kargp_t)__builtin_amdgcn_kernarg_segment_ptr(); asm volatile("" : "+s"(p_)); p_; })
__device__ __forceinline__ int fresh_tid() { int t = threadIdx.x; asm volatile("" : "+v"(t)); return t; }

__device__ __forceinline__ int win_orig_col(int n) { return n < 1280 ? n : (n < 4096 ? n + 16 : (n < 4112 ? n - 4096 + 1280 : -1)); }

__device__ __forceinline__ void transpose_item(const float* W, int ldw, bf16_t* WT, int k0, int n0, bool is_win, LAS float* scr, int lane) {
    const int np = n0 + (lane & 31); const int oc = is_win ? win_orig_col(np) : np;
#pragma unroll 8
    for (int i = 0; i < 32; ++i) { const int kk = 2 * i + (lane >> 5); scr[kk * 33 + (lane & 31)] = (oc >= 0) ? W[(size_t)(k0 + kk) * ldw + oc] : 0.f; }
    asm volatile("s_waitcnt lgkmcnt(0)" ::: "memory");
    const int c = lane & 7;
#pragma unroll
    for (int j = 0; j < 4; ++j) { const int n = (lane >> 3) + 8 * j; const LAS float* s = scr + (8 * c) * 33 + n;
        u32x4 o; o.x = pk2(s[0 * 33], s[1 * 33]); o.y = pk2(s[2 * 33], s[3 * 33]); o.z = pk2(s[4 * 33], s[5 * 33]); o.w = pk2(s[6 * 33], s[7 * 33]);
        *(u32x4*)(WT + (size_t)(n0 + n) * 1024 + k0 + 8 * c) = o; }
    asm volatile("s_waitcnt lgkmcnt(0)" ::: "memory");
}

__device__ __forceinline__ void transpose_layer(kargp_t ap, ldsp lds, int l, int gw, int NGW, int w, int lane) {
    bf16_t* WIN = (bf16_t*)(ap->ws + WS_WIN) + (size_t)l * NIN * 1024; bf16_t* WOUT = (bf16_t*)(ap->ws + WS_WOUT) + (size_t)l * 1024 * 1024;
    LAS float* scr = (LAS float*)(lds + w * 8448);
    for (int it = gw; it < 2176 + 512; it += NGW) {
        if (it < 2176) { const int kb = it / 136, nb = it % 136; transpose_item(ap->w_in + (size_t)l * 1024 * NINR, NINR, WIN, kb * 64, nb * 32, true, scr, lane); }
        else { const int r = it - 2176, kb = r / 32, nb = r % 32; transpose_item(ap->w_out + (size_t)l * 1024 * 1024, 1024, WOUT, kb * 64, nb * 32, false, scr, lane); }
    }
}

__device__ __forceinline__ void prologue(ldsp lds, int G) {
    const kargp_t ap = KARGS();
    const int tid = fresh_tid(), lane = tid & 63, w = tid >> 6;
    const int gw = blockIdx.x * 8 + w, NGW = G * 8;
    transpose_layer(ap, lds, 0, gw, NGW, w, lane);
    const int gt = blockIdx.x * 512 + tid, NGT = G * 512;
    float* BIAS = (float*)(ap->ws + WS_BIAS); float* ROPE = (float*)(ap->ws + WS_ROPE); bf16_t* WSB = (bf16_t*)(ap->ws + WS_WSB2);
    for (int i = gt; i < DEPTH * NIN; i += NGT) { const int l = i / NIN, n = i % NIN, oc = win_orig_col(n); BIAS[i] = oc >= 0 ? ap->b_in[l * NINR + oc] : 0.f; }
    for (int i = gt; i < DEPTH * 4 * 128 * 128; i += NGT) WSB[i] = f2bf(ap->w_s[i]);
    for (int i = gt; i < 96 * 16; i += NGT) { const int p = i >> 4, f = i & 15; const float pos = (float)(p < 32 ? p : p - 32);
        const float inv = powf(10000.f, -(float)f / 16.f); const float ang = pos * inv; ROPE[2 * i] = cosf(ang); ROPE[2 * i + 1] = sinf(ang); }
    __syncthreads();
    float* MOD = (float*)(ap->ws + WS_MOD);
    LAS float* SC = (LAS float*)lds;
    LAS float* RED = (LAS float*)(lds + 33 * 1024 * 4);
    bool table = false;
    for (int item = blockIdx.x; item < DEPTH * 48; item += G) {
        if (!table) { for (int i = tid; i < 33 * 1024; i += 512) { const float v = (i < 32 * 1024) ? ap->c[i] : ap->c_ctx[i - 32 * 1024]; SC[i] = silu_f(v); } table = true; }
        __syncthreads();
        const int l = item / 48, j0 = (item % 48) * 64;
        const float* wm = ap->w_mod + (size_t)l * 1024 * 3072 + j0 + lane;
        float acc[33];
#pragma unroll
        for (int r = 0; r < 33; ++r) acc[r] = 0.f;
#pragma unroll 4
        for (int k = w * 128; k < w * 128 + 128; k += 4) {
            const float w0 = wm[(size_t)k * 3072], w1 = wm[(size_t)(k + 1) * 3072], w2 = wm[(size_t)(k + 2) * 3072], w3 = wm[(size_t)(k + 3) * 3072];
#pragma unroll
            for (int r = 0; r < 33; ++r) { const f32x4 s = *(const LAS f32x4*)(SC + r * 1024 + k); acc[r] += (s[0] * w0 + s[1] * w1) + (s[2] * w2 + s[3] * w3); }
        }
        for (int ww = 0; ww < 8; ++ww) {
            if (w == ww) {
#pragma unroll
                for (int r = 0; r < 33; ++r) { if (ww == 0) RED[r * 64 + lane] = acc[r]; else RED[r * 64 + lane] += acc[r]; }
            }
            __syncthreads();
        }
        for (int i = tid; i < 33 * 64; i += 512) { const int r = i >> 6, j = i & 63; MOD[((size_t)l * 33 + r) * 3072 + j0 + j] = RED[i] + ap->b_mod[l * 3072 + j0 + j]; }
        __syncthreads();
    }
}

__device__ __forceinline__ void rowpass(int l, int G) {
    const kargp_t ap = KARGS();
    const int tid = fresh_tid(), lane = tid & 63, w = tid >> 6;
    const int gw = blockIdx.x * 8 + w, NGW = G * 8;
    const int nrows = (l == DEPTH) ? ML : MTOT;
    float* XC = (float*)(ap->ws + WS_XC); bf16_t* HL = (bf16_t*)(ap->ws + WS_HL); const float* MOD = (const float*)(ap->ws + WS_MOD);
#pragma unroll 4
    for (int m = gw; m < nrows; m += NGW) {
        const bool lat = m < ML;
        const float* src = (l == 0) ? (lat ? ap->x + (size_t)m * DM : ap->ctx + (size_t)(m - ML) * DM) : (lat ? ap->out + (size_t)m * DM : XC + (size_t)(m - ML) * DM);
        f32x4 v[4];
#pragma unroll
        for (int j = 0; j < 4; ++j) v[j] = *(const f32x4*)(src + 4 * lane + 256 * j);
        if (l > 0) {
            float s = 0.f;
#pragma unroll
            for (int j = 0; j < 4; ++j) s += (v[j][0] + v[j][1]) + (v[j][2] + v[j][3]);
            const float mean = wave_sum(s) * (1.f / DM); float s2 = 0.f;
#pragma unroll
            for (int j = 0; j < 4; ++j) { v[j] = v[j] - mean; s2 += (v[j][0] * v[j][0] + v[j][1] * v[j][1]) + (v[j][2] * v[j][2] + v[j][3] * v[j][3]); }
            const float rstd = 1.f / sqrtf(wave_sum(s2) * (1.f / DM) + LN_EPS);
            float* dst = lat ? ap->out + (size_t)m * DM : XC + (size_t)(m - ML) * DM;
            if (l < DEPTH && lane == 0) { float* st = (float*)(ap->ws + WS_STATS) + (size_t)m * 2; st[0] = mean; st[1] = rstd; }
#pragma unroll
            for (int j = 0; j < 4; ++j) { const f32x4 g = *(const f32x4*)(ap->ln_g + (l - 1) * DM + 4 * lane + 256 * j), bb = *(const f32x4*)(ap->ln_b + (l - 1) * DM + 4 * lane + 256 * j);
                v[j] = v[j] * rstd * g + bb; if (l == DEPTH) *(f32x4*)(dst + 4 * lane + 256 * j) = v[j]; }
        }
        if (l < DEPTH) {
            float s = 0.f;
#pragma unroll
            for (int j = 0; j < 4; ++j) s += (v[j][0] + v[j][1]) + (v[j][2] + v[j][3]);
            const float mean = wave_sum(s) * (1.f / DM); float s2 = 0.f;
#pragma unroll
            for (int j = 0; j < 4; ++j) { v[j] = v[j] - mean; s2 += (v[j][0] * v[j][0] + v[j][1] * v[j][1]) + (v[j][2] * v[j][2] + v[j][3] * v[j][3]); }
            const float rstd = 1.f / sqrtf(wave_sum(s2) * (1.f / DM) + LN_EPS);
            const int bidx = lat ? (m >> 11) : 32;
            const float* md = MOD + ((size_t)l * 33 + bidx) * 3072;
            bf16_t* o = HL + (size_t)m * DM;
#pragma unroll
            for (int j = 0; j < 4; ++j) { const f32x4 sh = *(const f32x4*)(md + 4 * lane + 256 * j), sc = *(const f32x4*)(md + 1024 + 4 * lane + 256 * j);
                const f32x4 h = v[j] * rstd * (sc + 1.f) + sh; u32x2 pk; pk.x = pk2(h[0], h[1]); pk.y = pk2(h[2], h[3]); *(u32x2*)(o + 4 * lane + 256 * j) = pk; }
        }
    }
}

constexpr int AT_KB = 16384, AT_BUF = 32768, AT_OB = 0, AT_OS = 65536;
__device__ __forceinline__ void at_glds16(const void* gsrc, unsigned lds_dst) { unsigned keep;
    asm volatile("s_mov_b32 %0, m0\n\ts_mov_b32 m0, %2\n\ts_nop 0\n\tglobal_load_lds_dwordx4 %1, off\n\ts_mov_b32 m0, %0" : "=&s"(keep) : "v"(gsrc), "s"(lds_dst) : "memory"); }
__device__ __forceinline__ void attn_item(ldsp lds, int l, int b, int h, int qb, bool is_ctx, float lam, float lam_init) {
    const kargp_t ap = KARGS();
    const bf16_t* __restrict__ P = (const bf16_t*)(ap->ws + WS_P); bf16_t* __restrict__ mix = (bf16_t*)(ap->ws + WS_HL); const float* __restrict__ da_g = ap->da_g + l * 128;
    const int tid = fresh_tid(), lane = tid & 63, w = __builtin_amdgcn_readfirstlane(tid >> 6), r32 = lane & 31, hh = lane >> 5;
    const int c = w >> 2, wq = w & 3;
    const int qrow0 = (is_ctx ? ML + b * CTXL : b * SEQ) + qb * 128;
    bf16x8 qf[4];
    { const bf16_t* qp = P + (size_t)(qrow0 + wq * 32 + r32) * NIN + C_DAQ + h * 128 + c * 64 + 8 * hh;
#pragma unroll
      for (int ks = 0; ks < 4; ++ks) qf[ks] = *(const bf16x8*)(qp + 16 * ks); }
    f32x16 o[4];
#pragma unroll
    for (int d = 0; d < 4; ++d)
#pragma unroll
        for (int r = 0; r < 16; ++r) o[d][r] = 0.f;
    float mrun = 0.f, lrun = 0.f;
    f32x16 negm;
#pragma unroll
    for (int r = 0; r < 16; ++r) negm[r] = 0.f;
    const int ntiles = is_ctx ? 4 : 36;
    const int drow = lane >> 4, dpc = lane & 15;
    const unsigned ldsw = (unsigned)w * 2048u;
    const int vq = (lane & 15) >> 2, vlo = ((lane >> 4) & 1) * 2 + ((lane & 3) >> 1), vhalf8 = (lane & 1) * 8, vtr_row = (4 * hh + vq) * 256;
#define AT_TILE_ROW(t) (is_ctx ? (ML + b * CTXL + (t) * 64) : ((t) < 32 ? b * SEQ + (t) * 64 : ML + b * CTXL + ((t) - 32) * 64))
#define AT_DMA(t, bufo) do { const bf16_t* rp_ = P + (size_t)(AT_TILE_ROW(t) + 8 * w + drow) * NIN + h * 128; \
        _Pragma("unroll") for (int j_ = 0; j_ < 2; ++j_) { const int rr_ = 8 * w + 4 * j_ + drow; \
            at_glds16(rp_ + (size_t)(4 * j_) * NIN + C_DAK + ((dpc ^ (rr_ & 15)) << 3), (unsigned)__builtin_amdgcn_readfirstlane((int)(lds0 + (unsigned)(bufo) + ldsw + j_ * 1024))); \
            at_glds16(rp_ + (size_t)(4 * j_) * NIN + C_DAV + ((dpc ^ ((rr_ & 3) << 2)) << 3), (unsigned)__builtin_amdgcn_readfirstlane((int)(lds0 + (unsigned)(bufo) + AT_KB + ldsw + j_ * 1024))); } } while (0)
    const unsigned lds0 = (unsigned)(size_t)lds;
    __syncthreads();
#define AT_BAR() do { __builtin_amdgcn_s_barrier(); asm volatile("" ::: "memory"); } while (0)
    AT_DMA(0, 0); AT_DMA(1, AT_BUF);
    asm volatile("s_waitcnt vmcnt(4)" ::: "memory");
    AT_BAR();
    if (c == 1) AT_BAR();
    int bo = 0, bn = 2 * AT_BUF;
    for (int t = 0; t < ntiles; ++t) {
        f32x16 p0, p1;
#pragma unroll
        for (int ks = 0; ks < 4; ++ks) {
            const bf16x8 k0 = *(const LAS bf16x8*)(lds + bo + r32 * 256 + (((c * 8 + 2 * ks + hh) ^ (r32 & 15)) << 4));
            const bf16x8 k1 = *(const LAS bf16x8*)(lds + bo + (32 + r32) * 256 + (((c * 8 + 2 * ks + hh) ^ (r32 & 15)) << 4));
            if (ks == 0) { p0 = MFMA32(k0, qf[0], negm); p1 = MFMA32(k1, qf[0], negm); }
            else { p0 = MFMA32(k0, qf[ks], p0); p1 = MFMA32(k1, qf[ks], p1); }
        }
        float tm = fmaxf(fmaxf(p0[0], p0[1]), p1[0]);
#pragma unroll
        for (int r = 1; r < 16; ++r) tm = fmaxf(fmaxf(tm, p0[r]), p1[r]);
        tm = fmaxf(tm, xshf<32>(tm));
        if (t == 0) {
            mrun = tm;
#pragma unroll
            for (int r = 0; r < 16; ++r) { p0[r] -= tm; p1[r] -= tm; negm[r] = -mrun; }
        } else if (__any(tm > 8.f)) {
            const float dl = fmaxf(tm, 0.f), alpha = __builtin_amdgcn_exp2f(-dl);
            mrun += dl; lrun *= alpha;
#pragma unroll
            for (int r = 0; r < 16; ++r) { p0[r] -= dl; p1[r] -= dl; negm[r] = -mrun; }
#pragma unroll
            for (int d = 0; d < 4; ++d)
#pragma unroll
                for (int r = 0; r < 16; ++r) o[d][r] *= alpha;
        }
        float ls = 0.f;
#pragma unroll
        for (int r = 0; r < 16; ++r) { p0[r] = __builtin_amdgcn_exp2f(p0[r]); p1[r] = __builtin_amdgcn_exp2f(p1[r]); ls += p0[r] + p1[r]; }
        lrun += ls;
        bf16x8 pw[4];
#pragma unroll
        for (int kb = 0; kb < 2; ++kb)
#pragma unroll
            for (int s = 0; s < 2; ++s) {
                float pv[8];
#pragma unroll
                for (int e = 0; e < 8; ++e) pv[e] = kb ? p1[8 * s + e] : p0[8 * s + e];
                pw[kb * 2 + s] = pack8(pv);
            }
        asm volatile("s_waitcnt vmcnt(0) lgkmcnt(0)" ::: "memory");
        AT_BAR();
        if (t + 2 < ntiles) AT_DMA(t + 2, bn);
#pragma unroll
        for (int kb = 0; kb < 2; ++kb)
#pragma unroll
            for (int s = 0; s < 2; ++s) {
#pragma unroll
                for (int d = 0; d < 4; ++d) {
                    const int off = bo + AT_KB + vtr_row + (kb * 32 + 16 * s) * 256 + (((d ^ vq) * 4 + vlo) << 4) + vhalf8;
                    const s16x4 lo = __builtin_bit_cast(s16x4, __builtin_amdgcn_ds_read_tr16_b64_v4i16((LAS s16x4*)(lds + off)));
                    const s16x4 hi = __builtin_bit_cast(s16x4, __builtin_amdgcn_ds_read_tr16_b64_v4i16((LAS s16x4*)(lds + off + 8 * 256)));
                    const bf16x8 afrag = {lo[0], lo[1], lo[2], lo[3], hi[0], hi[1], hi[2], hi[3]};
                    o[d] = MFMA32(afrag, pw[kb * 2 + s], o[d]);
                }
            }
        asm volatile("s_waitcnt lgkmcnt(0)" ::: "memory");
        AT_BAR();
        bo = (bo == 2 * AT_BUF) ? 0 : bo + AT_BUF; bn = (bn == 2 * AT_BUF) ? 0 : bn + AT_BUF;
    }
    if (c == 0) AT_BAR();
#undef AT_BAR
#undef AT_TILE_ROW
#undef AT_DMA
    { const float lt = lrun + xshf<32>(lrun); const float inv = 1.f / lt;
#pragma unroll
      for (int d = 0; d < 4; ++d)
#pragma unroll
          for (int r = 0; r < 16; ++r) o[d][r] *= inv; }
    __syncthreads();
    if (c == 1) {
#pragma unroll
        for (int d = 0; d < 4; ++d)
#pragma unroll
            for (int r = 0; r < 16; ++r) *(LAS float*)(lds + AT_OB + ((wq * 64 + d * 16 + r) * 64 + lane) * 4) = o[d][r];
    }
    __syncthreads();
    if (c == 0) {
        float ss = 0.f;
#pragma unroll
        for (int d = 0; d < 4; ++d)
#pragma unroll
            for (int r = 0; r < 16; ++r) { const float o1 = *(const LAS float*)(lds + AT_OB + ((wq * 64 + d * 16 + r) * 64 + lane) * 4); const float v = o[d][r] - lam * o1; o[d][r] = v; ss += v * v; }
        ss += xshf<32>(ss);
        const float rs = rsqrtf(ss * (1.f / 128.f) + LN_EPS) * (1.f - lam_init);
#pragma unroll
        for (int d = 0; d < 4; ++d)
#pragma unroll
            for (int r = 0; r < 16; ++r) *(LAS float*)(lds + AT_OS + ((wq * 32 + r32) * 132 + d * 32 + crow(r, hh)) * 4) = o[d][r] * rs;
    }
    __syncthreads();
    if (c == 0) {
#pragma unroll 2
        for (int it = 0; it < 8; ++it) {
            const int id = it * 64 + lane, row = id >> 4, ch = id & 15;
            const f32x4 a0 = *(const LAS f32x4*)(lds + AT_OS + ((wq * 32 + row) * 132 + ch * 8) * 4), a1 = *(const LAS f32x4*)(lds + AT_OS + ((wq * 32 + row) * 132 + ch * 8 + 4) * 4);
            const size_t grow = (size_t)(qrow0 + wq * 32 + row);
            const bf16x8 z = *(const bf16x8*)(P + grow * NIN + C_DAZ + h * 128 + ch * 8);
            const f32x4 g0 = *(const f32x4*)(da_g + ch * 8), g1 = *(const f32x4*)(da_g + ch * 8 + 4);
            float y[8];
#pragma unroll
            for (int e = 0; e < 4; ++e) { y[e] = a0[e] * g0[e] * silu_f(bf2f(z[e])); y[4 + e] = a1[e] * g1[e] * silu_f(bf2f(z[4 + e])); }
            *(bf16x8*)(mix + grow * DM + 256 + h * 128 + ch * 8) = pack8(y);
        }
    }
}

constexpr int SG_V = 0, SG_YS = 73728;
__device__ __forceinline__ void sgu_item(ldsp lds, int l, int row0) {
    const kargp_t ap = KARGS();
    const bf16_t* __restrict__ P = (const bf16_t*)(ap->ws + WS_P); bf16_t* __restrict__ mix = (bf16_t*)(ap->ws + WS_HL);
    const bf16_t* __restrict__ wsb = (const bf16_t*)(ap->ws + WS_WSB2) + (size_t)l * 4 * 128 * 128;
    const float* __restrict__ sg_g = ap->sg_g + l * 256; const float* __restrict__ sg_b = ap->sg_b + l * 256; const float* __restrict__ b_s = ap->b_s + l * 4 * 128;
    const int tid = fresh_tid(), lane = tid & 63, w = __builtin_amdgcn_readfirstlane(tid >> 6), r32 = lane & 31, hh = lane >> 5;
    {
        const int tok = tid >> 2, part = tid & 3;
        const bf16_t* rp = P + (size_t)(row0 + tok) * NIN + C_SGV + part * 64;
        float x[64]; float s = 0.f;
#pragma unroll
        for (int i = 0; i < 8; ++i) { const bf16x8 v = *(const bf16x8*)(rp + 8 * i);
#pragma unroll
            for (int e = 0; e < 8; ++e) { x[8 * i + e] = gelu_fast(bf2f(v[e])); s += x[8 * i + e]; } }
        s += xshf<1>(s); s += xshf<2>(s);
        const float mean = s * (1.f / 256.f); float s2 = 0.f;
#pragma unroll
        for (int e = 0; e < 64; ++e) { x[e] -= mean; s2 += x[e] * x[e]; }
        s2 += xshf<1>(s2); s2 += xshf<2>(s2);
        const float rstd = rsqrtf(s2 * (1.f / 256.f) + LN_EPS);
#pragma unroll
        for (int i = 0; i < 8; ++i) {
            const f32x4 g0 = *(const f32x4*)(sg_g + part * 64 + 8 * i), g1 = *(const f32x4*)(sg_g + part * 64 + 8 * i + 4), b0 = *(const f32x4*)(sg_b + part * 64 + 8 * i), b1 = *(const f32x4*)(sg_b + part * 64 + 8 * i + 4);
            float y[8];
#pragma unroll
            for (int e = 0; e < 4; ++e) { y[e] = x[8 * i + e] * rstd * g0[e] + b0[e]; y[4 + e] = x[8 * i + 4 + e] * rstd * g1[e] + b1[e]; }
            *(LAS bf16x8*)(lds + SG_V + tok * 576 + (part * 64 + 8 * i) * 2) = pack8(y);
        }
    }
    __syncthreads();
    const int pblk = w >> 1, dblk = w & 1;
    const int vtr = (8 * hh + ((lane & 15) >> 2)) * 576 + (dblk * 32 + 16 * ((lane >> 4) & 1) + 4 * (lane & 3)) * 2;
    for (int g = 0; g < 4; ++g) {
        const bf16_t* rq0 = P + (size_t)(row0 + (tid >> 3)) * NIN + g * 64 + (tid & 7) * 8; const bf16_t* rq1 = rq0 + (size_t)64 * NIN;
        const bf16x8 pu0 = *(const bf16x8*)(rq0 + C_SGU), pz0 = *(const bf16x8*)(rq0 + C_SGZ), pu1 = *(const bf16x8*)(rq1 + C_SGU), pz1 = *(const bf16x8*)(rq1 + C_SGZ);
        f32x16 acc;
#pragma unroll
        for (int r = 0; r < 16; ++r) acc[r] = 0.f;
        const bf16_t* wp = wsb + (size_t)g * 128 * 128 + (size_t)(pblk * 32 + r32) * 128 + 8 * hh;
#pragma unroll
        for (int ks = 0; ks < 8; ++ks) {
            const bf16x8 af = *(const bf16x8*)(wp + 16 * ks);
            const int off = SG_V + vtr + (16 * ks) * 576 + g * 128;
            const s16x4 lo = __builtin_bit_cast(s16x4, __builtin_amdgcn_ds_read_tr16_b64_v4i16((LAS s16x4*)(lds + off)));
            const s16x4 hi = __builtin_bit_cast(s16x4, __builtin_amdgcn_ds_read_tr16_b64_v4i16((LAS s16x4*)(lds + off + 4 * 576)));
            const bf16x8 bfr = {lo[0], lo[1], lo[2], lo[3], hi[0], hi[1], hi[2], hi[3]};
            acc = MFMA32(af, bfr, acc);
        }
#pragma unroll
        for (int r = 0; r < 16; ++r) { const int p = pblk * 32 + crow(r, hh); *(LAS float*)(lds + SG_YS + (p * 68 + dblk * 32 + r32) * 4) = acc[r] + b_s[g * 128 + p]; }
        __syncthreads();
#pragma unroll
        for (int i = 0; i < 2; ++i) {
            const int id = tid + 512 * i, p = id >> 3, ch = id & 7;
            const f32x4 v0 = *(const LAS f32x4*)(lds + SG_YS + (p * 68 + ch * 8) * 4), v1 = *(const LAS f32x4*)(lds + SG_YS + (p * 68 + ch * 8 + 4) * 4);
            const bf16x8 u = i ? pu1 : pu0, z = i ? pz1 : pz0;
            float y[8];
#pragma unroll
            for (int e = 0; e < 4; ++e) { y[e] = gelu_fast(bf2f(u[e])) * v0[e] * silu_f(bf2f(z[e])); y[4 + e] = gelu_fast(bf2f(u[4 + e])) * v1[e] * silu_f(bf2f(z[4 + e])); }
            *(bf16x8*)(mix + (size_t)(row0 + p) * DM + 768 + g * 64 + ch * 8) = pack8(y);
        }
        __syncthreads();
    }
}

constexpr int MQ_QS = 0, MQ_KS = 18432, MQ_HS = 80896, MQ_SM = 115712;
constexpr int MA_V = 36864, MA_KW = 61440;
constexpr int MC_V = 36864, MC_CB0 = 61440, MC_CB1 = 70656;
__device__ __forceinline__ int ml_rec(int pair, int dir, int cid) { return (pair * 2 + dir) * 18 + cid; }

__device__ __forceinline__ void mlstm_A(ldsp lds, int l, int pair, int cid) {
    const kargp_t ap = KARGS();
    const bf16_t* __restrict__ P = (const bf16_t*)(ap->ws + WS_P); bf16_t* __restrict__ QK = (bf16_t*)(ap->ws + WS_QK);
    const float* __restrict__ GATES = (const float*)(ap->ws + WS_GATES);
    float* __restrict__ CLOC = (float*)(ap->ws + WS_CLOC); float* __restrict__ NLOC = (float*)(ap->ws + WS_NLOC); float* __restrict__ SCL = (float*)(ap->ws + WS_SCL);
    const float* __restrict__ conv_w = ap->conv_w + (size_t)l * 3 * 512; const float* __restrict__ conv_b = ap->conv_b + l * 512;
    const int tid = fresh_tid(), lane = tid & 63, w = __builtin_amdgcn_readfirstlane(tid >> 6), r32 = lane & 31, hh = lane >> 5;
    const int b = pair >> 2, h = pair & 3;
    const bool isctx = cid < 2; const int cpos = isctx ? cid : cid - 2, L = isctx ? CTXL : SEQ, c0 = cpos * 128;
    const size_t seqrow = isctx ? (size_t)(ML + b * CTXL) : (size_t)b * SEQ;
    LAS float* GI = (LAS float*)(lds + MQ_SM); LAS float* GF = GI + 256; LAS float* WG2 = GI + 512;
    __syncthreads();
#pragma unroll
    for (int i = 0; i < 2; ++i) {
        const int id = tid + 512 * i, r = id >> 3, ch = id & 7, tt = c0 + r;
        const bf16_t* rp = P + (seqrow + tt) * NIN;
#pragma unroll
        for (int which = 0; which < 2; ++which) {
            const int colP = (which ? C_MLK : C_MLQ) + h * 64 + ch * 8, colW = (which ? 256 : 0) + h * 64 + ch * 8;
            const bf16x8 x0 = *(const bf16x8*)(rp + colP);
            bf16x8 xm = {0, 0, 0, 0, 0, 0, 0, 0}, xp = {0, 0, 0, 0, 0, 0, 0, 0};
            if (tt > 0) xm = *(const bf16x8*)(rp - NIN + colP);
            if (tt < L - 1) xp = *(const bf16x8*)(rp + NIN + colP);
            const f32x4 w0a = *(const f32x4*)(conv_w + colW), w0b = *(const f32x4*)(conv_w + colW + 4), w1a = *(const f32x4*)(conv_w + 512 + colW), w1b = *(const f32x4*)(conv_w + 512 + colW + 4);
            const f32x4 w2a = *(const f32x4*)(conv_w + 1024 + colW), w2b = *(const f32x4*)(conv_w + 1024 + colW + 4), cba = *(const f32x4*)(conv_b + colW), cbb = *(const f32x4*)(conv_b + colW + 4);
            float y[8];
#pragma unroll
            for (int e = 0; e < 8; ++e) {
                const float c0w = e < 4 ? w0a[e & 3] : w0b[e & 3], c1w = e < 4 ? w1a[e & 3] : w1b[e & 3], c2w = e < 4 ? w2a[e & 3] : w2b[e & 3], cbw = e < 4 ? cba[e & 3] : cbb[e & 3];
                float v = c0w * bf2f(xm[e]) + c1w * bf2f(x0[e]) + c2w * bf2f(xp[e]) + cbw;
                v = silu_f(v); if (which) v *= 0.125f; y[e] = v;
            }
            const bf16x8 pk = pack8(y);
            *(bf16x8*)(QK + (seqrow + tt) * 512 + which * 256 + h * 64 + ch * 8) = pk;
            if (which) *(LAS bf16x8*)(lds + MQ_KS + r * 144 + ch * 16) = pk;
        }
    }
#pragma unroll
    for (int i = 0; i < 2; ++i) {
        const int id = tid + 512 * i, r = id >> 3, ch = id & 7;
        *(LAS u32x4*)(lds + MA_V + r * 192 + ch * 16) = *(const u32x4*)(P + (seqrow + c0 + r) * NIN + C_MLV + h * 64 + ch * 8);
    }
    if (tid < 256) { const int dir = tid >> 7, s = tid & 127; const float* gp = GATES + (seqrow + c0 + s) * 16 + dir * 8 + h; GI[tid] = gp[0]; GF[tid] = logsigmoid_f(gp[4]); }
    __syncthreads();
    if (w < 2) {
        const int dir = w;
        const float f0 = GF[dir * 128 + 2 * lane], f1 = GF[dir * 128 + 2 * lane + 1], i0 = GI[dir * 128 + 2 * lane], i1 = GI[dir * 128 + 2 * lane + 1];
        const float s1 = f0 + f1; float x = s1;
#pragma unroll
        for (int off = 1; off < 64; off <<= 1) { const float y = lshf(x, lane - off); if (lane >= off) x += y; }
        const float tot = lshf(x, 63), ex = x - s1;
        const float b0 = dir ? tot - ex : ex + f0, b1 = dir ? tot - (ex + f0) : ex + s1;
        const float a0 = i0 - b0, a1 = i1 - b1;
        float sc_ = fmaxf(a0, a1), g0, g1;
        if (dir == 0) {
#pragma unroll
            for (int off = 1; off < 64; off <<= 1) { const float y = lshf(sc_, lane - off); if (lane >= off) sc_ = fmaxf(sc_, y); }
            float pe = lshf(sc_, lane - 1); if (lane == 0) pe = -3.0e38f;
            g0 = fmaxf(pe, a0); g1 = sc_;
        } else {
#pragma unroll
            for (int off = 1; off < 64; off <<= 1) { const float y = lshf(sc_, lane + off); if (lane + off < 64) sc_ = fmaxf(sc_, y); }
            float pe = lshf(sc_, lane + 1); if (lane == 63) pe = -3.0e38f;
            g1 = fmaxf(pe, a1); g0 = sc_;
        }
        const float mx = lshf(sc_, dir == 0 ? 63 : 0);
        { float* gp = (float*)(const_cast<bf16_t*>(P) + (seqrow + c0 + 2 * lane) * NIN + 4096) + (h * 2 + dir) * 4;
          *(f32x4*)gp = (f32x4){a0, b0, g0, 0.f}; *(f32x4*)(gp + NIN / 2) = (f32x4){a1, b1, g1, 0.f}; }
        WG2[dir * 128 + 2 * lane] = __expf(a0 - mx); WG2[dir * 128 + 2 * lane + 1] = __expf(a1 - mx);
        if (lane == 0) { float* sc = SCL + (size_t)ml_rec(pair, dir, cid) * 4; sc[0] = tot; sc[1] = tot + mx; }
    }
    __syncthreads();
#pragma unroll
    for (int i = 0; i < 2; ++i) {
        const int id = tid + 512 * i, r = id >> 3, ch = id & 7;
        const bf16x8 kv = *(const LAS bf16x8*)(lds + MQ_KS + r * 144 + ch * 16);
#pragma unroll
        for (int dir = 0; dir < 2; ++dir) {
            const float wg = WG2[dir * 128 + r]; float y[8];
#pragma unroll
            for (int e = 0; e < 8; ++e) y[e] = bf2f(kv[e]) * wg;
            *(LAS bf16x8*)(lds + MA_KW + dir * 24576 + r * 192 + ch * 16) = pack8(y);
        }
    }
    __syncthreads();
    {
        const int dir = w >> 2, vb = (w >> 1) & 1, kb = w & 1; const int rec = ml_rec(pair, dir, cid);
        const int trb = (8 * hh + ((lane & 15) >> 2)) * 192 + (16 * ((lane >> 4) & 1) + 4 * (lane & 3)) * 2;
        const short one = (r32 == 0) ? (short)0x3F80 : (short)0;
        const bf16x8 ones = {one, one, one, one, one, one, one, one};
        f32x16 cl, nl;
#pragma unroll
        for (int r = 0; r < 16; ++r) { cl[r] = 0.f; nl[r] = 0.f; }
#pragma unroll
        for (int ks = 0; ks < 8; ++ks) {
            const int ao = MA_V + trb + (16 * ks) * 192 + vb * 64, bo_ = MA_KW + dir * 24576 + trb + (16 * ks) * 192 + kb * 64;
            const s16x4 al = __builtin_bit_cast(s16x4, __builtin_amdgcn_ds_read_tr16_b64_v4i16((LAS s16x4*)(lds + ao))), ah = __builtin_bit_cast(s16x4, __builtin_amdgcn_ds_read_tr16_b64_v4i16((LAS s16x4*)(lds + ao + 4 * 192)));
            const s16x4 bl = __builtin_bit_cast(s16x4, __builtin_amdgcn_ds_read_tr16_b64_v4i16((LAS s16x4*)(lds + bo_))), bh = __builtin_bit_cast(s16x4, __builtin_amdgcn_ds_read_tr16_b64_v4i16((LAS s16x4*)(lds + bo_ + 4 * 192)));
            const bf16x8 af = {al[0], al[1], al[2], al[3], ah[0], ah[1], ah[2], ah[3]}, bfr = {bl[0], bl[1], bl[2], bl[3], bh[0], bh[1], bh[2], bh[3]};
            cl = MFMA32(af, bfr, cl);
            if (vb == 0) nl = MFMA32(ones, bfr, nl);
        }
        float* cp = CLOC + (size_t)rec * 4096;
#pragma unroll
        for (int r = 0; r < 16; ++r) cp[(vb * 32 + crow(r, hh)) * 64 + kb * 32 + r32] = cl[r];
        if (vb == 0 && hh == 0) NLOC[(size_t)rec * 64 + kb * 32 + r32] = nl[0];
    }
}

__device__ __forceinline__ void mlstm_B(int l, int pair, int dir) {
    const kargp_t ap = KARGS();
    const float* __restrict__ CLOC = (const float*)(ap->ws + WS_CLOC); const float* __restrict__ NLOC = (const float*)(ap->ws + WS_NLOC);
    float* __restrict__ SCL = (float*)(ap->ws + WS_SCL); bf16_t* __restrict__ CPREV = (bf16_t*)(ap->ws + WS_CPREV); float* __restrict__ NPREV = (float*)(ap->ws + WS_NPREV);
    const int tid = fresh_tid();
    float c[8]; float n = 0.f, m = 0.f;
#pragma unroll
    for (int e = 0; e < 8; ++e) c[e] = 0.f;
    for (int s0 = 0; s0 < 18; s0 += 6) {
        f32x4 l0[6], l1[6]; float nl[6], bend[6], mloc[6]; int rec[6];
#pragma unroll
        for (int u = 0; u < 6; ++u) {
            const int step = s0 + u; const bool isctx = step < 2; const int cidx = isctx ? step : step - 2, nch = isctx ? 2 : 16;
            const int cpos = (dir == 0) ? cidx : nch - 1 - cidx, cid = isctx ? cpos : 2 + cpos;
            rec[u] = ml_rec(pair, dir, cid);
            l0[u] = *(const f32x4*)(CLOC + (size_t)rec[u] * 4096 + tid * 8); l1[u] = *(const f32x4*)(CLOC + (size_t)rec[u] * 4096 + tid * 8 + 4);
            nl[u] = (tid < 64) ? NLOC[(size_t)rec[u] * 64 + tid] : 0.f;
            bend[u] = SCL[(size_t)rec[u] * 4]; mloc[u] = SCL[(size_t)rec[u] * 4 + 1];
        }
#pragma unroll
        for (int u = 0; u < 6; ++u) {
            *(bf16x8*)(CPREV + (size_t)rec[u] * 4096 + tid * 8) = pack8(c);
            if (tid < 64) NPREV[(size_t)rec[u] * 64 + tid] = n;
            if (tid == 0) SCL[(size_t)rec[u] * 4 + 2] = m;
            const float m_new = fmaxf(bend[u] + m, mloc[u]), fa = __expf(bend[u] + m - m_new), fs = __expf(mloc[u] - m_new);
#pragma unroll
            for (int e = 0; e < 4; ++e) { c[e] = fa * c[e] + fs * l0[u][e]; c[4 + e] = fa * c[4 + e] + fs * l1[u][e]; }
            n = fa * n + fs * nl[u]; m = m_new;
        }
    }
}

__device__ __forceinline__ void mlstm_C(ldsp lds, int l, int pair, int cid) {
    const kargp_t ap = KARGS();
    const bf16_t* __restrict__ P = (const bf16_t*)(ap->ws + WS_P); bf16_t* __restrict__ mix = (bf16_t*)(ap->ws + WS_HL); const bf16_t* __restrict__ QK = (const bf16_t*)(ap->ws + WS_QK);
    const float* __restrict__ SCL = (const float*)(ap->ws + WS_SCL); const bf16_t* __restrict__ CPREV = (const bf16_t*)(ap->ws + WS_CPREV); const float* __restrict__ NPREV = (const float*)(ap->ws + WS_NPREV);
    const float* __restrict__ ml_g = ap->ml_g + l * 256;
    const int tid = fresh_tid(), lane = tid & 63, w = __builtin_amdgcn_readfirstlane(tid >> 6), r32 = lane & 31, hh = lane >> 5;
    const int b = pair >> 2, h = pair & 3;
    const bool isctx = cid < 2; const int cpos = isctx ? cid : cid - 2, c0 = cpos * 128;
    const size_t seqrow = isctx ? (size_t)(ML + b * CTXL) : (size_t)b * SEQ;
    LAS float* GA = (LAS float*)(lds + MQ_SM);
    LAS float* GB = GA + 256;
    LAS float* GM = GA + 512;
    LAS float* NV = GA + 768;
    const int rec0 = ml_rec(pair, 0, cid), rec1 = ml_rec(pair, 1, cid);
    const float mp0 = SCL[(size_t)rec0 * 4 + 2], mp1 = SCL[(size_t)rec1 * 4 + 2];
    const bf16_t* rpe = P + (seqrow + c0 + (tid >> 2)) * NIN + h * 64 + (tid & 3) * 16;
    const bf16x8 o0 = *(const bf16x8*)(rpe + C_MLO), o1 = *(const bf16x8*)(rpe + C_MLO + 8), z0 = *(const bf16x8*)(rpe + C_MLZ), z1 = *(const bf16x8*)(rpe + C_MLZ + 8);
    __syncthreads();
#pragma unroll
    for (int i = 0; i < 2; ++i) {
        const int id = tid + 512 * i, r = id >> 3, ch = id & 7;
        const bf16_t* rp = QK + (seqrow + c0 + r) * 512 + h * 64 + ch * 8;
        *(LAS u32x4*)(lds + MQ_QS + r * 144 + ch * 16) = *(const u32x4*)rp;
        *(LAS u32x4*)(lds + MQ_KS + r * 144 + ch * 16) = *(const u32x4*)(rp + 256);
    }
#pragma unroll
    for (int i = 0; i < 2; ++i) {
        const int id = tid + 512 * i, r = id >> 3, ch = id & 7;
        *(LAS u32x4*)(lds + MC_V + r * 192 + ch * 16) = *(const u32x4*)(P + (seqrow + c0 + r) * NIN + C_MLV + h * 64 + ch * 8);
    }
    *(LAS u32x4*)(lds + MC_CB0 + (tid >> 3) * 144 + (tid & 7) * 16) = *(const u32x4*)(CPREV + (size_t)rec0 * 4096 + tid * 8);
    *(LAS u32x4*)(lds + MC_CB1 + (tid >> 3) * 144 + (tid & 7) * 16) = *(const u32x4*)(CPREV + (size_t)rec1 * 4096 + tid * 8);
    if (tid < 128) NV[tid] = NPREV[(size_t)(tid < 64 ? rec0 : rec1) * 64 + (tid & 63)];
    if (tid < 256) { const int dir = tid >> 7, tok = tid & 127;
        const f32x4 g = *(const f32x4*)((const float*)(P + (seqrow + c0 + tok) * NIN + 4096) + (h * 2 + dir) * 4);
        GA[tid] = g[0]; GB[tid] = g[1]; GM[tid] = g[2]; }
    __syncthreads();
    {
        const int jb = w & 3, vh = w >> 2, j = jb * 32 + r32;
        bf16x8 qf[4];
#pragma unroll
        for (int ks = 0; ks < 4; ++ks) qf[ks] = *(const LAS bf16x8*)(lds + MQ_QS + j * 144 + (16 * ks + 8 * hh) * 2);
        f32x16 tot;
#pragma unroll
        for (int r = 0; r < 16; ++r) tot[r] = 0.f;
#pragma unroll
        for (int dir = 0; dir < 2; ++dir) {
            const float m_state = dir ? mp1 : mp0;
            const float e_j = fmaxf(m_state, GM[dir * 128 + j]), b_j = GB[dir * 128 + j];
            f32x16 acc;
#pragma unroll
            for (int r = 0; r < 16; ++r) acc[r] = 0.f;
            float dsum = 0.f;
            const int sb_lo = dir ? jb : 0, sb_hi = dir ? 3 : jb;
            for (int sb = sb_lo; sb <= sb_hi; ++sb) {
                f32x16 st;
#pragma unroll
                for (int r = 0; r < 16; ++r) st[r] = 0.f;
#pragma unroll
                for (int ks = 0; ks < 4; ++ks) { const bf16x8 kf = *(const LAS bf16x8*)(lds + MQ_KS + (sb * 32 + r32) * 144 + (16 * ks + 8 * hh) * 2); st = MFMA32(kf, qf[ks], st); }
#pragma unroll
                for (int r = 0; r < 16; ++r) { const int s = sb * 32 + crow(r, hh); const float a_s = GA[dir * 128 + s];
                    const bool ok = dir ? (s >= j) : (s <= j);
                    const float val = ok ? st[r] * __expf(fminf(a_s - e_j, 0.f)) : 0.f; st[r] = val; dsum += val; }
#pragma unroll
                for (int s2 = 0; s2 < 2; ++s2) {
                    float pv[8];
#pragma unroll
                    for (int e = 0; e < 8; ++e) pv[e] = st[8 * s2 + e];
                    const bf16x8 bfrag = pack8(pv);
                    const int off = MC_V + (sb * 32 + 16 * s2 + 4 * hh + ((lane & 15) >> 2)) * 192 + (vh * 32 + 16 * ((lane >> 4) & 1) + 4 * (lane & 3)) * 2;
                    const s16x4 lo = __builtin_bit_cast(s16x4, __builtin_amdgcn_ds_read_tr16_b64_v4i16((LAS s16x4*)(lds + off))), hi = __builtin_bit_cast(s16x4, __builtin_amdgcn_ds_read_tr16_b64_v4i16((LAS s16x4*)(lds + off + 8 * 192)));
                    const bf16x8 afrag = {lo[0], lo[1], lo[2], lo[3], hi[0], hi[1], hi[2], hi[3]};
                    acc = MFMA32(afrag, bfrag, acc);
                }
            }
            f32x16 acc2;
#pragma unroll
            for (int r = 0; r < 16; ++r) acc2[r] = 0.f;
#pragma unroll
            for (int ks = 0; ks < 4; ++ks) { const bf16x8 cf = *(const LAS bf16x8*)(lds + (dir ? MC_CB1 : MC_CB0) + (vh * 32 + r32) * 144 + (16 * ks + 8 * hh) * 2); acc2 = MFMA32(cf, qf[ks], acc2); }
            const float w_int = __expf(m_state - e_j);
            float nq = 0.f;
#pragma unroll
            for (int ks = 0; ks < 4; ++ks)
#pragma unroll
                for (int e = 0; e < 8; ++e) nq += bf2f(qf[ks][e]) * NV[dir * 64 + 16 * ks + 8 * hh + e];
            nq += xshf<32>(nq); dsum += xshf<32>(dsum);
            const float den = w_int * nq + dsum;
            const float inv = 1.f / fmaxf(fabsf(den), __expf(-(b_j + e_j)));
#pragma unroll
            for (int r = 0; r < 16; ++r) tot[r] += (acc[r] + w_int * acc2[r]) * inv;
        }
#pragma unroll
        for (int r = 0; r < 16; ++r) *(LAS float*)(lds + MQ_HS + (j * 68 + vh * 32 + crow(r, hh)) * 4) = tot[r];
    }
    __syncthreads();
    {
        const int j = tid >> 2, qv = tid & 3; const size_t row = seqrow + c0 + j;
        float x[16]; float s = 0.f;
#pragma unroll
        for (int q4 = 0; q4 < 4; ++q4) {
            const f32x4 hs = *(const LAS f32x4*)(lds + MQ_HS + (j * 68 + qv * 16 + q4 * 4) * 4);
#pragma unroll
            for (int e = 0; e < 4; ++e) { const int idx = q4 * 4 + e; const float og = sigmoid_f(bf2f(idx < 8 ? o0[idx & 7] : o1[idx & 7])); x[idx] = og * hs[e]; s += x[idx]; }
        }
        s += xshf<1>(s); s += xshf<2>(s);
        const float mean = s * (1.f / 64.f); float s2 = 0.f;
#pragma unroll
        for (int e = 0; e < 16; ++e) { x[e] -= mean; s2 += x[e] * x[e]; }
        s2 += xshf<1>(s2); s2 += xshf<2>(s2);
        const float rstd = rsqrtf(s2 * (1.f / 64.f) + LN_EPS);
        float y[16];
#pragma unroll
        for (int e = 0; e < 16; ++e) y[e] = x[e] * rstd * ml_g[h * 64 + qv * 16 + e] * silu_f(bf2f(e < 8 ? z0[e & 7] : z1[e & 7]));
        bf16_t* mp = mix + row * DM + h * 64 + qv * 16;
        *(bf16x8*)mp = pack8(y); *(bf16x8*)(mp + 8) = pack8(y + 8);
    }
}

typedef unsigned int gu32_unused_t;
#define XB_TMO      128
#define XB_XCNT(j)  (256  + 64 * (j))
#define XB_XSUB(j)  (1280 + 64 * (j))
#define XB_XGEN(j)  (2304 + 64 * (j))
#define XB_TOP      3328
#define XB_TOPGEN   3392
#define XCD_BAR_WORDS 3456
#define XB_SPIN_CAP (1u << 18)

__device__ __forceinline__ unsigned xb_ld(unsigned* p)              { return __hip_atomic_load(p, __ATOMIC_RELAXED, __HIP_MEMORY_SCOPE_AGENT); }
__device__ __forceinline__ unsigned xb_add(unsigned* p, unsigned v) { return __hip_atomic_fetch_add(p, v, __ATOMIC_RELAXED, __HIP_MEMORY_SCOPE_AGENT); }
__device__ __forceinline__ unsigned xb_xcc_id() { return (unsigned)__builtin_amdgcn_s_getreg((3 << 11) | 20) & 0xFu; }
#define XB_SPIN(cond, bar) do { unsigned _sp = 0; while (cond) { __builtin_amdgcn_s_sleep(1); \
    if ((++_sp & 255u) == 0u) { if (xb_ld(&(bar)[XB_TMO])) break; if (_sp > XB_SPIN_CAP) { atomicAdd(&(bar)[XB_TMO], 1u); break; } } } } while (0)

struct XcdBarrier {
    unsigned* bar; unsigned x;
    volatile LAS unsigned* st;
};

__device__ __forceinline__ XcdBarrier xcd_barrier_post(unsigned* bar, volatile LAS unsigned* st) {
    XcdBarrier b; b.bar = bar; b.x = xb_xcc_id(); b.st = st;
    if (threadIdx.x == 0) (void)xb_add(&bar[XB_XCNT(b.x)], 1u);
    return b;
}
__device__ __forceinline__ void xcd_barrier_complete(unsigned* bar, unsigned x, unsigned& nloc, unsigned& nx) {
    const unsigned G = gridDim.x * gridDim.y * gridDim.z;
    unsigned sum, cnt, mine, sp = 0u;
    for (;;) {
        sum = 0u; cnt = 0u; mine = 0u;
#pragma unroll
        for (unsigned j = 0; j < 16; ++j) { const unsigned c = xb_ld(&bar[XB_XCNT(j)]); sum += c; cnt += (c > 0u) ? 1u : 0u; mine = (j == x) ? c : mine; }
        if (sum == G) break;
        __builtin_amdgcn_s_sleep(1);
        if ((++sp & 255u) == 0u) { if (xb_ld(&bar[XB_TMO])) break; if (sp > XB_SPIN_CAP) { atomicAdd(&bar[XB_TMO], 1u); break; } }
    }
    nloc = mine > 0u ? mine : 1u; nx = cnt > 0u ? cnt : 1u;
}

__device__ __forceinline__ void xcd_barrier(const XcdBarrier& b) {
    asm volatile("s_waitcnt vmcnt(0)" ::: "memory");
    __syncthreads();
    if (threadIdx.x == 0) {
        unsigned* bar = b.bar;
        __builtin_amdgcn_s_waitcnt(0);
        unsigned nloc = b.st[0], nx = b.st[1];
        if (nloc == 0u) { xcd_barrier_complete(bar, b.x, nloc, nx); b.st[0] = nloc; b.st[1] = nx; }
        const unsigned old = xb_add(&bar[XB_XSUB(b.x)], 1u);
        const unsigned gen = old / nloc;
        if (old + 1u == (gen + 1u) * nloc) {
            __builtin_amdgcn_fence(__ATOMIC_RELEASE, "agent");
            asm volatile("s_waitcnt vmcnt(0)" ::: "memory");
            const unsigned og = xb_add(&bar[XB_TOP], 1u);
            const unsigned tg = og / nx;
            if (og + 1u == (tg + 1u) * nx) xb_add(&bar[XB_TOPGEN], 1u);
            else XB_SPIN(xb_ld(&bar[XB_TOPGEN]) == tg, bar);
            __builtin_amdgcn_fence(__ATOMIC_ACQUIRE, "agent");
            xb_add(&bar[XB_XGEN(b.x)], 1u);
            asm volatile("s_waitcnt vmcnt(0)" ::: "memory");
        } else {
            XB_SPIN(xb_ld(&bar[XB_XGEN(b.x)]) == gen, bar);
            __builtin_amdgcn_fence(__ATOMIC_ACQUIRE, "agent");
            asm volatile("s_waitcnt vmcnt(0)" ::: "memory");
        }
    }
    __syncthreads();
}

template <int SP> __device__ __forceinline__ void mixer_sub(ldsp lds, int l, int rep, float lam, float lam_init) {
    const bool need_ctx = l < DEPTH - 1;
    unsigned* ctl; { const kargp_t ap = KARGS(); ctl = (unsigned*)(ap->ws + WS_CTL) + rep * 2048; }
    const int ncc = need_ctx ? 18 : 16;
    const int n_ac = need_ctx ? 32 : 0, n_c = 16 * ncc, n_sg = need_ctx ? 72 : 64;
    const int total = SP == 0 ? 128 + 288 : (SP == 1 ? 32 : 128 + n_ac + n_c + n_sg);
    volatile LAS int* slot = (volatile LAS int*)(lds + LDS_SLOT);
    const int myx = (int)(__builtin_amdgcn_s_getreg((3 << 11) | 20) & 7u);
    for (int k = 0; k < 8; ++k) {
        const int x = (myx + k) & 7;
        unsigned* ctr = ctl + ((l * 3 + SP) * 8 + x) * 16;
        for (;;) {
            __syncthreads();
            if (threadIdx.x == 0) *slot = (int)atomicAdd(ctr, 1u);
            __syncthreads();
            int it = *slot;
            it = __builtin_amdgcn_readfirstlane(it);
            if (it >= total) break;
            if (SP == 0) {
                if (it < 128) { const int pair = x * 16 + (it >> 4); attn_item(lds, l, pair >> 2, pair & 3, it & 15, false, lam, lam_init); continue; }
                it -= 128;
                mlstm_A(lds, l, x * 16 + it / 18, it % 18);
            } else if (SP == 1) {
                mlstm_B(l, x * 16 + (it >> 1), it & 1);
            } else {
                if (it < 128) { it += 128; const int pair = x * 16 + (it >> 4); attn_item(lds, l, pair >> 2, pair & 3, it & 15, false, lam, lam_init); continue; }
                it -= 128;
                if (it < n_ac) { const int pair = x * 16 + (it >> 1); attn_item(lds, l, pair >> 2, pair & 3, it & 1, true, lam, lam_init); continue; }
                it -= n_ac;
                if (it < n_sg) {
                    const int row0 = (it < 64) ? (4 * x + (it >> 4)) * SEQ + (it & 15) * 128 : ML + (4 * x + ((it - 64) >> 1)) * CTXL + ((it - 64) & 1) * 128;
                    sgu_item(lds, l, row0); continue; }
                it -= n_sg;
                mlstm_C(lds, l, x * 16 + it / ncc, (it % ncc) + (need_ctx ? 0 : 2));
            }
        }
    }
}
__device__ __forceinline__ void mixer_phase(ldsp lds, int l, const XcdBarrier& xb, int rep = 0) {
    float lam, lam_init;
    { const kargp_t ap = KARGS();
      float d1 = 0.f, d2 = 0.f;
      const float* q1 = ap->lq1 + l * 64; const float* k1 = ap->lk1 + l * 64; const float* q2 = ap->lq2 + l * 64; const float* k2 = ap->lk2 + l * 64;
      for (int i = 0; i < 64; ++i) { d1 += q1[i] * k1[i]; d2 += q2[i] * k2[i]; }
      lam_init = 0.8f - 0.6f * expf(-0.3f * (float)l);
      lam = expf(d1) - expf(d2) + lam_init; }
    mixer_sub<0>(lds, l, rep, lam, lam_init);
    xcd_barrier(xb);
    mixer_sub<1>(lds, l, rep, lam, lam_init);
    xcd_barrier(xb);
    mixer_sub<2>(lds, l, rep, lam, lam_init);
}

struct OrderLast {
    pg8::StaticOrder base; int G, c;
    __device__ void init(int G_, int c_) { base.init(ML, 4096, G_, c_); G = G_; c = c_; }
    __device__ bool next(int i, pg8::Unit& u) const {
        const int L = i * G + c;
        if (L < 4096) return base.next(i, u);
        const int r = L - 4096; if (r >= 32 * 6) return false;
        const int live[6] = {1, 2, 7, 8, 9, 10};
        const int j = r % 6; u.pm = ML / 256 + r / 6; u.pn = j == 0 ? 1 : j == 1 ? 2 : j == 2 ? 7 : j == 3 ? 8 : j == 4 ? 9 : 10; (void)live; return true;
    }
    __device__ __forceinline__ void a_ready(const pg8::Unit&) const {}
    __device__ __forceinline__ void done(const pg8::Unit&) const {}
};
typedef float f32x4g __attribute__((ext_vector_type(4)));
__device__ __forceinline__ void inproj_phase(ldsp lds, int l, int G) {
    const kargp_t ap = KARGS(); unsigned char* ws = ap->ws;
    {
        pg8::Gemm g{(const pg8::bf16_t*)(ws + WS_HL), (const pg8::bf16_t*)(ws + WS_WIN) + (size_t)l * NIN * 1024, MTOT, 4096, DM};
        pg8::EpiIn E{(pg8::bf16_t*)(ws + WS_P), (float*)(ws + WS_GATES), (const float*)(ws + WS_BIAS) + l * NIN, (const float*)(ws + WS_ROPE)};
        if (l == DEPTH - 1) {
            OrderLast S; S.init(G, (int)blockIdx.x);
            pg8::gemm_phase<pg8::EpiIn, OrderLast, true, true>(lds, g, S, E);
        } else {
            pg8::StaticOrder S; S.init(MTOT, 4096, G, (int)blockIdx.x);
            pg8::gemm_phase<pg8::EpiIn, pg8::StaticOrder, true, true>(lds, g, S, E);
        }
    }
    {
        const int tid = fresh_tid(), lane = tid & 63, w = tid >> 6, fr = lane & 15, fq = lane >> 4;
        const bf16_t* HL = (const bf16_t*)(ws + WS_HL); const bf16_t* WG = (const bf16_t*)(ws + WS_WIN) + ((size_t)l * NIN + 4096) * 1024;
        float* GATES = (float*)(ws + WS_GATES); const float bias = ((const float*)(ws + WS_BIAS))[l * NIN + 4096 + fr];
        for (int task = blockIdx.x * 8 + w; task < MTOT / 16; task += G * 8) {
            const bf16_t* ap_ = HL + (size_t)(task * 16 + fr) * DM + 8 * fq; const bf16_t* bp_ = WG + (size_t)fr * DM + 8 * fq;
            f32x4g acc = {0.f, 0.f, 0.f, 0.f};
#pragma unroll 8
            for (int kk = 0; kk < 32; ++kk) acc = __builtin_amdgcn_mfma_f32_16x16x32_bf16(*(const bf16x8*)(ap_ + kk * 32), *(const bf16x8*)(bp_ + kk * 32), acc, 0, 0, 0);
#pragma unroll
            for (int r = 0; r < 4; ++r) GATES[(size_t)(task * 16 + fq * 4 + r) * 16 + fr] = acc[r] + bias;
        }
    }
}
__device__ __forceinline__ void outproj_phase(ldsp lds, int l, int G) {
    const kargp_t ap = KARGS(); unsigned char* ws = ap->ws;
    const int Mo = (l == DEPTH - 1) ? ML : MTOT;
    pg8::Gemm g{(const pg8::bf16_t*)(ws + WS_HL), (const pg8::bf16_t*)(ws + WS_WOUT) + (size_t)l * 1024 * 1024, Mo, DM, DM};
    pg8::StaticOrder S; S.init(Mo, DM, G, (int)blockIdx.x);
    pg8::EpiOut E{l == 0 ? ap->x : ap->out, l == 0 ? ap->ctx : (const float*)(ws + WS_XC), ap->out, (float*)(ws + WS_XC), (const float*)(ws + WS_MOD) + (size_t)l * 33 * 3072 + 2048,
                  (const float*)(ws + WS_STATS), ap->ln_g + (l > 0 ? l - 1 : 0) * DM, ap->ln_b + (l > 0 ? l - 1 : 0) * DM, l > 0 ? 1 : 0};
    pg8::gemm_phase<pg8::EpiOut, pg8::StaticOrder, true, true>(lds, g, S, E);
    if (l + 1 < DEPTH) {
        const int nwg = (Mo / 256) * (DM / 256), nfull = nwg - (nwg / G) * G;
        const int c = (int)blockIdx.x;
        if (c >= nfull) { const int tid = fresh_tid(); transpose_layer(ap, lds, l + 1, (c - nfull) * 8 + (tid >> 6), (G - nfull) * 8, tid >> 6, tid & 63); }
    }
}
template <int L> __device__ __forceinline__ void layer_body(ldsp lds, int G, const XcdBarrier& xb) {
    inproj_phase(lds, L, G);
    xcd_barrier(xb);
    mixer_phase(lds, L, xb);
    xcd_barrier(xb);
    outproj_phase(lds, L, G);
    xcd_barrier(xb);
    rowpass(L + 1, G);
    if (L + 1 < DEPTH) xcd_barrier(xb);
}
__global__ void __launch_bounds__(512, 2) fwd_kernel(Args a) {
    extern __shared__ __attribute__((aligned(16))) unsigned char lds_raw[];
    cg::grid_group grid = cg::this_grid();
    ldsp lds = (ldsp)lds_raw;
    const int G = gridDim.x;
    volatile LAS unsigned* xst = (volatile LAS unsigned*)(lds + LDS_SLOT + 32);
    if (threadIdx.x == 0) { xst[0] = 0u; xst[1] = 0u; }
    __syncthreads();
    const XcdBarrier xb = xcd_barrier_post((unsigned*)(a.ws + WS_CTL) + 8192, xst);
    prologue(lds, G);
    grid.sync();
    rowpass(0, G);
    xcd_barrier(xb);
    layer_body<0>(lds, G, xb); layer_body<1>(lds, G, xb); layer_body<2>(lds, G, xb); layer_body<3>(lds, G, xb);
}

extern "C" void kernel_launch(void* const* d_in, const int* in_sizes, int n_in, void* d_out, int out_size, void* d_ws, size_t ws_size, hipStream_t stream) {
    static int grid = 0;
    if (grid == 0) {
        int dev = 0, cus = 0, per_cu = 0;
        if (hipGetDevice(&dev) != hipSuccess || hipDeviceGetAttribute(&cus, hipDeviceAttributeMultiprocessorCount, dev) != hipSuccess) { fprintf(stderr, "device query failed\n"); grid = -1; return; }
        if (hipFuncSetAttribute((const void*)fwd_kernel, hipFuncAttributeMaxDynamicSharedMemorySize, LDS_BYTES) != hipSuccess) { fprintf(stderr, "hipFuncSetAttribute failed\n"); grid = -1; return; }
        if (hipOccupancyMaxActiveBlocksPerMultiprocessor(&per_cu, (const void*)fwd_kernel, 512, LDS_BYTES) != hipSuccess || per_cu < 1) fprintf(stderr, "occupancy query: %d\n", per_cu);
        (void)hipGetLastError();
        if (ws_size < WS_END) { fprintf(stderr, "workspace too small: %zu < %zu\n", ws_size, (size_t)WS_END); grid = -1; return; }
        grid = cus;
    }
    if (grid < 0) return;
    (void)hipMemsetAsync((char*)d_ws + WS_CTL, 0, CTL_BYTES, stream);
    Args a{};
    const float** ap = (const float**)&a;
    for (int i = 0; i < 23; ++i) ap[i] = (const float*)d_in[i];
    a.out = (float*)d_out; a.ws = (unsigned char*)d_ws;
    void* args[] = {&a};
    hipError_t e = hipLaunchCooperativeKernel((const void*)fwd_kernel, dim3(grid), dim3(512), args, LDS_BYTES, stream);
    if (e != hipSuccess) fprintf(stderr, "cooperative launch failed: %s (grid %d)\n", hipGetErrorString(e), grid);
}
```
